# Optimizing an MI355X kernel written in HIP

```python
import jax, jax.numpy as jnp
from jax import lax
import numpy as np

D_MODEL = 2048
BATCH = 16
SEQ = 256
DEPTH = 2
DEC_BATCH = 8
DEC_SEQ = 2048
PAST_LEN = 512

GRID_W = 64
HEAD_DIM = 128
N_Q_HEADS = 8
N_KV_HEADS = 2
Q_PER_KV = N_Q_HEADS // N_KV_HEADS
ATT_WIDTH = N_Q_HEADS * HEAD_DIM
KV_WIDTH = N_KV_HEADS * HEAD_DIM
CONV_WIDTH = D_MODEL - ATT_WIDTH
CONF_WIDTH = 31
SHORT_WIDTH = 3
WINDOW = 128
Q_BLOCK = 128
ROPE_THETA = 10000.0
EPS = 1e-6
NEG_INF = -1e30
IN0 = 3 * CONV_WIDTH + 2 * ATT_WIDTH + 2 * KV_WIDTH
IN1 = 4 * CONV_WIDTH + 2 * ATT_WIDTH + 2 * KV_WIDTH

kernel_name = "hybrid_dit_prefix_context_step"


def _split(x, sizes):
    idx, acc = [], 0
    for s in sizes[:-1]:
        acc += s
        idx.append(acc)
    return jnp.split(x, idx, axis=-1)


def rms_norm(x, g):
    xf = x.astype(jnp.float32)
    y = xf * lax.rsqrt(jnp.mean(xf * xf, axis=-1, keepdims=True) + EPS)
    return (y * g.astype(jnp.float32)).astype(x.dtype)


def layer_norm(x, g, b):
    xf = x.astype(jnp.float32)
    mu = jnp.mean(xf, axis=-1, keepdims=True)
    var = jnp.mean(jnp.square(xf - mu), axis=-1, keepdims=True)
    y = (xf - mu) * lax.rsqrt(var + EPS)
    return (y * g.astype(jnp.float32) + b.astype(jnp.float32)).astype(x.dtype)


def adaln(cond, w_mod, b_mod):
    m = jax.nn.silu(cond) @ w_mod + b_mod
    shift, scale, gate = jnp.split(m, 3, axis=-1)
    return shift[:, None, :], scale[:, None, :], gate[:, None, :]


def depthwise_conv(x, w):
    k = w.shape[0]
    return lax.conv_general_dilated(
        x, w[:, None, :].astype(x.dtype), window_strides=(1,),
        padding=[(k // 2, k // 2)], dimension_numbers=("NWC", "WIO", "NWC"),
        feature_group_count=x.shape[-1])


def rope_tables(n_tokens):
    rows = n_tokens // GRID_W
    r = jnp.repeat(jnp.arange(rows), GRID_W).astype(jnp.float32)
    col = jnp.tile(jnp.arange(GRID_W), rows).astype(jnp.float32)
    half = HEAD_DIM // 2
    inv = ROPE_THETA ** (-jnp.arange(0, half, 2, dtype=jnp.float32) / half)
    ang_r = r[:, None] * inv
    ang_c = col[:, None] * inv
    ang = jnp.concatenate([ang_r, ang_r, ang_c, ang_c], axis=-1)
    return jnp.cos(ang)[None, :, None, :], jnp.sin(ang)[None, :, None, :]


def _rot_half(u):
    u1, u2 = jnp.split(u, 2, axis=-1)
    return jnp.concatenate([-u2, u1], axis=-1)


def apply_rope(x, cos, sin):
    xr, xc = jnp.split(x, 2, axis=-1)
    xrot = jnp.concatenate([_rot_half(xr), _rot_half(xc)], axis=-1)
    return (x.astype(jnp.float32) * cos + xrot.astype(jnp.float32) * sin).astype(x.dtype)


def attend(q, k, v, bias, sink):
    s = jnp.einsum("bqhgd,bkhd->bhgqk", q, k).astype(jnp.float32) * (HEAD_DIM ** -0.5)
    if bias is not None:
        s = s + bias
    if sink is None:
        p = jax.nn.softmax(s, axis=-1)
    else:
        sk = sink.astype(jnp.float32).reshape(N_KV_HEADS, Q_PER_KV)[None, :, :, None, None]
        sk = jnp.broadcast_to(sk, s.shape[:-1] + (1,))
        p = jax.nn.softmax(jnp.concatenate([s, sk], axis=-1), axis=-1)[..., :-1]
    return jnp.einsum("bhgqk,bkhd->bqhgd", p.astype(v.dtype), v)


def dense_attention(q, k, v, sink):
    bn, s, h, hd = q.shape
    nb = s // Q_BLOCK
    qb = q.reshape(bn, nb, Q_BLOCK, N_KV_HEADS, Q_PER_KV, hd).swapaxes(0, 1)
    out = lax.map(lambda qi: attend(qi, k, v, None, sink), qb)
    return out.swapaxes(0, 1).reshape(bn, s, h * hd)


def window_attention(q, k, v, k_ctx, v_ctx, sink):
    bn, s, h, hd = q.shape
    nb = s // Q_BLOCK
    span = Q_BLOCK + 2 * WINDOW
    n_ctx = k_ctx.shape[1]
    pad = ((0, 0), (WINDOW, WINDOW), (0, 0), (0, 0))
    kp = jnp.pad(k, pad)
    vp = jnp.pad(v, pad)
    qb = q.reshape(bn, nb, Q_BLOCK, N_KV_HEADS, Q_PER_KV, hd).swapaxes(0, 1)
    ctx_bias = jnp.zeros((Q_BLOCK, n_ctx), jnp.float32)

    def block(args):
        qi, bi = args
        start = bi * Q_BLOCK
        kb = lax.dynamic_slice_in_dim(kp, start, span, axis=1)
        vb = lax.dynamic_slice_in_dim(vp, start, span, axis=1)
        qpos = start + jnp.arange(Q_BLOCK)
        kpos = start - WINDOW + jnp.arange(span)
        valid = ((kpos[None, :] >= 0) & (kpos[None, :] < s)
                 & (jnp.abs(qpos[:, None] - kpos[None, :]) <= WINDOW))
        bias = jnp.concatenate(
            [ctx_bias, jnp.where(valid, 0.0, NEG_INF).astype(jnp.float32)], axis=-1)
        return attend(qi, jnp.concatenate([k_ctx, kb], axis=1),
                      jnp.concatenate([v_ctx, vb], axis=1), bias, sink)

    out = lax.map(block, (qb, jnp.arange(nb)))
    return out.swapaxes(0, 1).reshape(bn, s, h * hd)


def mixer_even(h, w_in, conv_w, conv_b, ln_g, ln_b, qn_g, kn_g, w_out, rope, ctx_kv):
    bn, s, _ = h.shape
    proj = h @ w_in
    ga, gb, gate_a, q, k, v, gate_b = _split(
        proj, [CONV_WIDTH, CONV_WIDTH, CONV_WIDTH, ATT_WIDTH, KV_WIDTH, KV_WIDTH, ATT_WIDTH])
    a = ga * jax.nn.sigmoid(gb)
    a = depthwise_conv(a, conv_w) + conv_b
    a = jax.nn.silu(layer_norm(a, ln_g, ln_b)) * jax.nn.silu(gate_a)
    q = rms_norm(q.reshape(bn, s, N_Q_HEADS, HEAD_DIM), qn_g)
    k = rms_norm(k.reshape(bn, s, N_KV_HEADS, HEAD_DIM), kn_g)
    v = v.reshape(bn, s, N_KV_HEADS, HEAD_DIM)
    if ctx_kv is None:
        k_all, v_all = k, v
    else:
        q = apply_rope(q, *rope)
        k = apply_rope(k, *rope)
        k_all = jnp.concatenate([ctx_kv[0], k], axis=1)
        v_all = jnp.concatenate([ctx_kv[1], v], axis=1)
    b = dense_attention(q, k_all, v_all, None) * jax.nn.silu(gate_b)
    return jnp.concatenate([a, b], axis=-1) @ w_out, k, v


def mixer_odd(h, w_in, sink, short_w, w_out, rope, ctx_kv):
    bn, s, _ = h.shape
    proj = h @ w_in
    q, k, v, gate_c, db, dc, dx, gate_d = _split(
        proj, [ATT_WIDTH, KV_WIDTH, KV_WIDTH, ATT_WIDTH,
               CONV_WIDTH, CONV_WIDTH, CONV_WIDTH, CONV_WIDTH])
    q = q.reshape(bn, s, N_Q_HEADS, HEAD_DIM)
    k = k.reshape(bn, s, N_KV_HEADS, HEAD_DIM)
    v = v.reshape(bn, s, N_KV_HEADS, HEAD_DIM)
    if ctx_kv is None:
        c_out = dense_attention(q, k, v, sink)
    else:
        q = apply_rope(q, *rope)
        kr = apply_rope(k, *rope)
        c_out = window_attention(q, kr, v, ctx_kv[0], ctx_kv[1], sink)
    c_out = c_out * jax.nn.silu(gate_c)
    d_out = db * depthwise_conv(dc * dx, short_w) * jax.nn.silu(gate_d)
    return jnp.concatenate([c_out, d_out], axis=-1) @ w_out, k, v


def setup_inputs(seed: int = 0) -> dict:
    key = jax.random.key(seed)
    ks = iter(jax.random.split(key, 40))
    f32 = jnp.float32

    def nrm(shape, scale):
        return jax.random.normal(next(ks), shape, f32) * scale

    def gain(n):
        return 1.0 + nrm((n,), 0.02)

    d = D_MODEL
    kv_shape = (DEC_BATCH, PAST_LEN, N_KV_HEADS, HEAD_DIM)
    return {
        "x_prompt": nrm((BATCH, SEQ, d), 1.0),
        "x_sample": nrm((DEC_BATCH, DEC_SEQ, d), 1.0),
        "cache_k0": nrm(kv_shape, 1.0),
        "cache_v0": nrm(kv_shape, 1.0),
        "cache_k1": nrm(kv_shape, 1.0),
        "cache_v1": nrm(kv_shape, 1.0),
        "c": nrm((DEC_BATCH, d), 1.0),
        "c_ctx": nrm((d,), 1.0),
        "mod_w0": nrm((d, 3 * d), 0.5 * d ** -0.5),
        "mod_b0": nrm((3 * d,), 0.01),
        "norm_g0": gain(d),
        "w_in0": nrm((d, IN0), d ** -0.5),
        "conv_w0": nrm((CONF_WIDTH, CONV_WIDTH), CONF_WIDTH ** -0.5),
        "conv_b0": nrm((CONV_WIDTH,), 0.01),
        "ln_g0": gain(CONV_WIDTH),
        "ln_b0": nrm((CONV_WIDTH,), 0.01),
        "q_norm_g0": gain(HEAD_DIM),
        "k_norm_g0": gain(HEAD_DIM),
        "w_out0": nrm((d, d), d ** -0.5),
        "mod_w1": nrm((d, 3 * d), 0.5 * d ** -0.5),
        "mod_b1": nrm((3 * d,), 0.01),
        "norm_g1": gain(d),
        "w_in1": nrm((d, IN1), d ** -0.5),
        "sink1": nrm((N_Q_HEADS,), 0.5),
        "short_w1": nrm((SHORT_WIDTH, CONV_WIDTH), SHORT_WIDTH ** -0.5),
        "w_out1": nrm((d, d), d ** -0.5),
        "final_norm_g": gain(d),
    }


def reference(x_prompt, x_sample, cache_k0, cache_v0, cache_k1, cache_v1, c, c_ctx,
              mod_w0, mod_b0, norm_g0, w_in0, conv_w0, conv_b0, ln_g0, ln_b0,
              q_norm_g0, k_norm_g0, w_out0,
              mod_w1, mod_b1, norm_g1, w_in1, sink1, short_w1, w_out1, final_norm_g):
    rope = rope_tables(x_sample.shape[1])
    caches = [(cache_k0, cache_v0), (cache_k1, cache_v1)]
    mods = [(mod_w0, mod_b0, norm_g0), (mod_w1, mod_b1, norm_g1)]
    cond_ctx = c_ctx[None, :]
    xp, xs = x_prompt, x_sample
    new_kv = []
    for layer in range(DEPTH):
        w_mod, b_mod, g = mods[layer]
        sh, sc, gt = adaln(cond_ctx, w_mod, b_mod)
        hp = rms_norm(xp, g) * (1.0 + sc) + sh
        sh2, sc2, gt2 = adaln(c, w_mod, b_mod)
        hs = rms_norm(xs, g) * (1.0 + sc2) + sh2
        if layer % 2 == 0:
            op, kc, vc = mixer_even(hp, w_in0, conv_w0, conv_b0, ln_g0, ln_b0,
                                    q_norm_g0, k_norm_g0, w_out0, rope, None)
            os_, _, _ = mixer_even(hs, w_in0, conv_w0, conv_b0, ln_g0, ln_b0,
                                   q_norm_g0, k_norm_g0, w_out0, rope, caches[layer])
        else:
            op, kc, vc = mixer_odd(hp, w_in1, sink1, short_w1, w_out1, rope, None)
            os_, _, _ = mixer_odd(hs, w_in1, sink1, short_w1, w_out1, rope, caches[layer])
        new_kv.append((kc, vc))
        xp = xp + gt * op
        xs = xs + gt2 * os_
    y_prompt = rms_norm(xp, final_norm_g)
    y_sample = rms_norm(xs, final_norm_g)
    return (y_prompt, y_sample, new_kv[0][0], new_kv[0][1], new_kv[1][0], new_kv[1][1])
```

```cpp
#include <hip/hip_runtime.h>
#include <cstdio>
#include <cstdint>
namespace pg8 {
#define PG8_LAS __attribute__((address_space(3)))
typedef unsigned short bf16_t;
typedef short bf16x8 __attribute__((ext_vector_type(8)));
typedef float f32x4 __attribute__((ext_vector_type(4)));
typedef unsigned u32x4 __attribute__((ext_vector_type(4)));
constexpr int BM = 256, BK = 64, HALF = 128, HTB = HALF * BK * 2  , STAGE_BYTES = 8 * HTB, NXCD = 8, WGM = 8;

__host__ __device__ __forceinline__ int lds_byte(int r, int c) { const int st = (r >> 4) * 2 + (c >> 5), rr = r & 15, cc = c & 31, ob = rr * 64 + cc * 2; return st * 1024 + (ob ^ (((ob >> 9) & 1) << 5)); }
__host__ __device__ __forceinline__ void stage_rc(int b, int& R, int& C) { const int st = b / 1024, sb = b % 1024, swz = sb ^ (((sb >> 9) & 1) << 5); R = (st >> 1) * 16 + swz / 64; C = (st & 1) * 32 + (swz % 64) / 2; }
__host__ __device__ __forceinline__ int perm32(int rho) { const int n = rho >> 4, i = rho & 15; return 8 * (i >> 2) + 4 * n + (i & 3); }

struct Unit { int pm, pn; };
struct Gemm { const bf16_t* A; const bf16_t* Bt; int M, N, K; };

struct StaticOrder {
    int nM, nN, nwg, G, c;
    __host__ __device__ void init(int M, int N, int G_, int c_) { nM = M / BM; nN = N / BM; nwg = nM * nN; G = G_; c = c_; }
    __host__ __device__ bool next(int i, Unit& u) const {
        const long L = (long)i * G + c; if (L >= nwg) return false;
        int wgid = (int)L; { const int q = nwg / NXCD, r = nwg % NXCD, xcd = wgid % NXCD, off = wgid / NXCD; wgid = (xcd < r ? xcd * (q + 1) : r * (q + 1) + (xcd - r) * q) + off; }
        const int nig = WGM * nN, gid = wgid / nig, fm = gid * WGM, gsz = (nM - fm) < WGM ? (nM - fm) : WGM;
        u.pm = fm + ((wgid % nig) % gsz); u.pn = (wgid % nig) / gsz; return true;
    }
    __device__ __forceinline__ void a_ready(const Unit&) const {}
    __device__ __forceinline__ void done(const Unit&) const {}
};

__device__ __forceinline__ unsigned cvt_pk_bf16(float lo, float hi) { unsigned r; asm volatile("v_cvt_pk_bf16_f32 %0, %1, %2" : "=v"(r) : "v"(lo), "v"(hi)); return r; }
typedef float f32x2 __attribute__((ext_vector_type(2)));
struct EpiProj {
    static constexpr bool PERM = true, AFTER_DRAIN = false;
    bf16_t* O; int ldc; int pn_a; float* out_a; int pn_b; float* out_b;
    __device__ __forceinline__ void operator()(const f32x4 (&acc)[2][2][4][2], const Unit& u, int wr, int wc, int fr, int fq) const {
        const int row0 = u.pm * BM + wr * 64 + fr, col0 = u.pn * BM + wc * 32 + 8 * fq;
#pragma unroll
        for (int ai = 0; ai < 2; ++ai)
#pragma unroll
            for (int m = 0; m < 4; ++m) { bf16_t* rowp = O + (size_t)(row0 + ai * HALF + m * 16) * ldc + col0;
#pragma unroll
                for (int bj = 0; bj < 2; ++bj) { const f32x4 v0 = acc[ai][bj][m][0], v1 = acc[ai][bj][m][1];
                    u32x4 w; w.x = cvt_pk_bf16(v0[0], v0[1]); w.y = cvt_pk_bf16(v0[2], v0[3]); w.z = cvt_pk_bf16(v1[0], v1[1]); w.w = cvt_pk_bf16(v1[2], v1[3]);
                    *(u32x4*)(rowp + bj * HALF) = w; } }
        float* side = nullptr;
        if (u.pm < 16) { if (u.pn == pn_a) side = out_a; else if (u.pn == pn_b) side = out_b; }
        if (side) {
#pragma unroll
            for (int ai = 0; ai < 2; ++ai)
#pragma unroll
                for (int m = 0; m < 4; ++m) { float* rowp = side + (size_t)(row0 + ai * HALF + m * 16) * 256 + wc * 32 + 8 * fq;
#pragma unroll
                    for (int bj = 0; bj < 2; ++bj) { *(f32x4*)(rowp + bj * HALF) = acc[ai][bj][m][0]; *(f32x4*)(rowp + bj * HALF + 4) = acc[ai][bj][m][1]; } }
        }
    }
};
struct EpiRes {
    static constexpr bool PERM = false, AFTER_DRAIN = false;
    const float* xp; const float* xs; float* out; const float* gate;
    __device__ __forceinline__ void operator()(const f32x4 (&acc)[2][2][4][2], const Unit& u, int wr, int wc, int fr, int fq) const {
        const int row0 = u.pm * BM + wr * 64 + fr, col0 = u.pn * BM + wc * 32 + 4 * fq;
        const int cr = u.pm < 16 ? 8 : ((u.pm - 16) >> 3);
        const float* g = gate + (size_t)cr * 6144 + col0;
        f32x4 gv[2][2];
#pragma unroll
        for (int bj = 0; bj < 2; ++bj)
#pragma unroll
            for (int n = 0; n < 2; ++n) gv[bj][n] = *(const f32x4*)(g + bj * HALF + n * 16);
#pragma unroll
        for (int ai = 0; ai < 2; ++ai)
#pragma unroll
            for (int m = 0; m < 4; ++m) { const int r = row0 + ai * HALF + m * 16;
                const float* base = (u.pm < 16 ? xp + (size_t)r * 2048 : xs + (size_t)(r - 4096) * 2048) + col0;
                float* o = out + (size_t)r * 2048 + col0;
#pragma unroll
                for (int bj = 0; bj < 2; ++bj)
#pragma unroll
                    for (int n = 0; n < 2; ++n) { const f32x4 bs = *(const f32x4*)(base + bj * HALF + n * 16); *(f32x4*)(o + bj * HALF + n * 16) = bs + gv[bj][n] * acc[ai][bj][m][n]; }
                if (m & 1) asm volatile("" ::: "memory"); }
    }
};

template <class Epi, class Sched, bool ALIGN_EPI = false, bool SP2 = false>
__device__ __forceinline__ void gemm_phase(PG8_LAS unsigned char* lds, const Gemm g, const Sched& S, const Epi& E) {
    const int tid = threadIdx.x, wid = __builtin_amdgcn_readfirstlane(tid >> 6), lane = tid & 63, wr = wid >> 2, wc = wid & 3, fr = lane & 15, fq = lane >> 4;
    const int K = g.K, nt = K / BK;
    unsigned voffA[2], voffB[2];
#pragma unroll
    for (int i = 0; i < 2; ++i) { int R, C; stage_rc(tid * 16 + i * 8192, R, C); const int Rb = Epi::PERM ? ((R & ~31) + perm32(R & 31)) : R;
        voffA[i] = (unsigned)(R * K + C) * 2u; voffB[i] = (unsigned)(Rb * K + C) * 2u; }
    const size_t kstep = (size_t)(BK * 2);
    const size_t hstep = (size_t)HALF * K * 2;
    const size_t tstep = 2 * hstep;
    const unsigned ldsw = (unsigned)wid * 1024u;
    const int aoff = lds_byte(wr * 64 + fr, fq * 8), boff = lds_byte(wc * 32 + fr, fq * 8);
#define PG8_SA(b, h) (((b) * 2 + (h)) * HTB)
#define PG8_SB(b, h) ((4 + (b) * 2 + (h)) * HTB)
#define PG8_STAGE(bufoff, gbase, voff) do { _Pragma("unroll") for (int _i = 0; _i < 2; ++_i) \
        __builtin_amdgcn_global_load_lds((const unsigned*)((const char*)(gbase) + (voff)[_i]), (PG8_LAS unsigned*)(lds + (bufoff) + ldsw + _i * 8192), 16, 0, 0); } while (0)
#define PG8_LDA(dst, b, h) do { _Pragma("unroll") for (int m = 0; m < 4; ++m) _Pragma("unroll") for (int k = 0; k < 2; ++k) dst[m][k] = *(const PG8_LAS bf16x8*)(lds + PG8_SA(b, h) + aoff + m * 2048 + k * 1024); } while (0)
#define PG8_LDB(dst, b, h) do { _Pragma("unroll") for (int n = 0; n < 2; ++n) _Pragma("unroll") for (int k = 0; k < 2; ++k) dst[n][k] = *(const PG8_LAS bf16x8*)(lds + PG8_SB(b, h) + boff + n * 2048 + k * 1024); } while (0)
#define PG8_MMA(ai, bj, At, Bt) do { __builtin_amdgcn_s_setprio(1); _Pragma("unroll") for (int m = 0; m < 4; ++m) _Pragma("unroll") for (int n = 0; n < 2; ++n) _Pragma("unroll") for (int k = 0; k < 2; ++k) \
        acc[ai][bj][m][n] = __builtin_amdgcn_mfma_f32_16x16x32_bf16(Bt[n][k], At[m][k], acc[ai][bj][m][n], 0, 0, 0); __builtin_amdgcn_s_setprio(0); } while (0)
#define PG8_WAIT_V(n) asm volatile("s_waitcnt vmcnt(" #n ")" ::: "memory")
#define PG8_WAIT_L(n) asm volatile("s_waitcnt lgkmcnt(" #n ")" ::: "memory")
#define PG8_BAR __builtin_amdgcn_s_barrier()
#define PG8_SCHED __builtin_amdgcn_sched_barrier(0)
    Unit cur, nxt; int ui = 0;
    if (!S.next(0, cur)) return;
    f32x4 acc[2][2][4][2];
#pragma unroll
    for (int a = 0; a < 2; ++a)
#pragma unroll
        for (int b = 0; b < 2; ++b)
#pragma unroll
            for (int m = 0; m < 4; ++m)
#pragma unroll
                for (int n = 0; n < 2; ++n) acc[a][b][m][n] = (f32x4){0.f, 0.f, 0.f, 0.f};
    bf16x8 At[4][2], B0[2][2], B1[2][2];
    const char* cA = (const char*)g.A + (size_t)cur.pm * tstep; const char* cB = (const char*)g.Bt + (size_t)cur.pn * tstep;
    S.a_ready(cur);
    if constexpr (SP2) {
        PG8_STAGE(PG8_SB(0, 0), cB, voffB); PG8_STAGE(PG8_SB(0, 1), cB + hstep, voffB); PG8_STAGE(PG8_SA(0, 0), cA, voffA); PG8_STAGE(PG8_SA(0, 1), cA + hstep, voffA);
        if (wr == 1) PG8_BAR;
        PG8_WAIT_V(2); PG8_BAR;
        PG8_STAGE(PG8_SB(1, 0), cB + kstep, voffB); PG8_STAGE(PG8_SA(1, 0), cA + kstep, voffA); PG8_STAGE(PG8_SB(1, 1), cB + hstep + kstep, voffB);
        PG8_WAIT_V(6); PG8_BAR;
    } else {
        PG8_STAGE(PG8_SB(0, 0), cB, voffB); PG8_STAGE(PG8_SA(0, 0), cA, voffA); PG8_STAGE(PG8_SB(0, 1), cB + hstep, voffB); PG8_STAGE(PG8_SA(0, 1), cA + hstep, voffA);
        if (wr == 1) PG8_BAR;
        PG8_WAIT_V(4); PG8_BAR;
        PG8_STAGE(PG8_SB(1, 0), cB + kstep, voffB); PG8_STAGE(PG8_SA(1, 0), cA + kstep, voffA); PG8_STAGE(PG8_SB(1, 1), cB + hstep + kstep, voffB);
        PG8_WAIT_V(6); PG8_BAR;
    }
    for (;;) {
        const bool has_next = S.next(ui + 1, nxt);
        const char* nA = has_next ? (const char*)g.A + (size_t)nxt.pm * tstep : cA; const char* nB = has_next ? (const char*)g.Bt + (size_t)nxt.pn * tstep : cB;
        for (int t = 0; t < nt; t += 2) {
            const bool last = (t == nt - 2);
            const char* a1 = cA + (size_t)(t + 1) * kstep;
            const char* a2 = last ? nA : cA + (size_t)(t + 2) * kstep; const char* b2 = last ? nB : cB + (size_t)(t + 2) * kstep;
            const char* a3 = a2 + kstep; const char* b3 = b2 + kstep;
            if (last && has_next) S.a_ready(nxt);
            if constexpr (SP2) {
            PG8_LDB(B0, 0, 0); PG8_LDB(B1, 0, 1); PG8_SCHED; PG8_LDA(At, 0, 0); PG8_STAGE(PG8_SA(1, 1), a1 + hstep, voffA);
            PG8_WAIT_V(8); PG8_WAIT_L(0); PG8_BAR; PG8_MMA(0, 0, At, B0); PG8_MMA(0, 1, At, B1); PG8_BAR; PG8_SCHED;
            PG8_LDA(At, 0, 1); PG8_STAGE(PG8_SB(0, 0), b2, voffB); PG8_STAGE(PG8_SB(0, 1), b2 + hstep, voffB); PG8_STAGE(PG8_SA(0, 0), a2, voffA);
            PG8_WAIT_V(8); PG8_WAIT_L(0); PG8_BAR; PG8_MMA(1, 0, At, B0); PG8_MMA(1, 1, At, B1); PG8_BAR; PG8_SCHED;
            PG8_LDB(B0, 1, 0); PG8_LDB(B1, 1, 1); PG8_SCHED; PG8_LDA(At, 1, 0); PG8_STAGE(PG8_SA(0, 1), a2 + hstep, voffA);
            PG8_WAIT_V(8); PG8_WAIT_L(0); PG8_BAR; PG8_MMA(0, 0, At, B0); PG8_MMA(0, 1, At, B1); PG8_BAR; PG8_SCHED;
            PG8_LDA(At, 1, 1); PG8_STAGE(PG8_SB(1, 0), b3, voffB); PG8_STAGE(PG8_SB(1, 1), b3 + hstep, voffB); PG8_STAGE(PG8_SA(1, 0), a3, voffA);
            PG8_WAIT_V(8); PG8_WAIT_L(0); PG8_BAR; PG8_MMA(1, 0, At, B0); PG8_MMA(1, 1, At, B1); PG8_BAR; PG8_SCHED;
            } else {
            PG8_LDB(B0, 0, 0); PG8_SCHED; PG8_LDA(At, 0, 0); PG8_STAGE(PG8_SA(1, 1), a1 + hstep, voffA);
            PG8_WAIT_L(8); PG8_BAR; PG8_WAIT_L(0); PG8_MMA(0, 0, At, B0); PG8_BAR; PG8_SCHED;
            PG8_LDB(B1, 0, 1); PG8_STAGE(PG8_SB(0, 0), b2, voffB);
            PG8_BAR; PG8_WAIT_L(0); PG8_MMA(0, 1, At, B1); PG8_BAR;
            PG8_LDA(At, 0, 1); PG8_STAGE(PG8_SA(0, 0), a2, voffA);
            PG8_BAR; PG8_WAIT_L(0); PG8_MMA(1, 0, At, B0); PG8_BAR; PG8_SCHED;
            PG8_STAGE(PG8_SB(0, 1), b2 + hstep, voffB);
            PG8_WAIT_V(6); PG8_BAR; PG8_MMA(1, 1, At, B1); PG8_BAR;
            PG8_LDB(B0, 1, 0); PG8_SCHED; PG8_LDA(At, 1, 0); PG8_STAGE(PG8_SA(0, 1), a2 + hstep, voffA);
            PG8_WAIT_L(8); PG8_BAR; PG8_WAIT_L(0); PG8_MMA(0, 0, At, B0); PG8_BAR; PG8_SCHED;
            PG8_LDB(B1, 1, 1); PG8_STAGE(PG8_SB(1, 0), b3, voffB);
            PG8_BAR; PG8_WAIT_L(0); PG8_MMA(0, 1, At, B1); PG8_BAR;
            PG8_LDA(At, 1, 1); PG8_STAGE(PG8_SA(1, 0), a3, voffA);
            PG8_BAR; PG8_WAIT_L(0); PG8_MMA(1, 0, At, B0); PG8_BAR; PG8_SCHED;
            PG8_STAGE(PG8_SB(1, 1), b3 + hstep, voffB);
            PG8_WAIT_V(6); PG8_BAR; PG8_MMA(1, 1, At, B1); PG8_BAR;
            }
        }
        if constexpr (ALIGN_EPI) { if (wr == 0) PG8_BAR; }
        if constexpr (!Epi::AFTER_DRAIN) { E(acc, cur, wr, wc, fr, fq); S.done(cur); }
        if (!has_next) break;
#pragma unroll
        for (int a = 0; a < 2; ++a)
#pragma unroll
            for (int b = 0; b < 2; ++b)
#pragma unroll
                for (int m = 0; m < 4; ++m)
#pragma unroll
                    for (int n = 0; n < 2; ++n) acc[a][b][m][n] = (f32x4){0.f, 0.f, 0.f, 0.f};
        cur = nxt; cA = nA; cB = nB; ++ui;
        if constexpr (ALIGN_EPI) { if (wr == 1) PG8_BAR; }
    }
    PG8_WAIT_V(0);
    if constexpr (!ALIGN_EPI) { if (wr == 0) PG8_BAR; }
    PG8_BAR;
    if constexpr (Epi::AFTER_DRAIN) { E.fused(acc, cur, wr, wc, fr, fq, lds, wid, lane); S.done(cur); }
#undef PG8_SA
#undef PG8_SB
#undef PG8_STAGE
#undef PG8_LDA
#undef PG8_LDB
#undef PG8_MMA
#undef PG8_WAIT_V
#undef PG8_WAIT_L
#undef PG8_BAR
#undef PG8_SCHED
}
}

#define GAS __attribute__((address_space(1)))
#define LAS __attribute__((address_space(3)))
typedef unsigned short bf16;
typedef unsigned v4u __attribute__((ext_vector_type(4)));
typedef float f32x4 __attribute__((ext_vector_type(4)));
typedef short bf16x8 __attribute__((ext_vector_type(8)));
typedef GAS unsigned gu32;
typedef GAS unsigned long long gu64;
#define RLX_AGENT __ATOMIC_RELAXED, __HIP_MEMORY_SCOPE_AGENT
#define LDS_WAIT() asm volatile("s_waitcnt lgkmcnt(0)" ::: "memory")
#define VM_WAIT() asm volatile("s_waitcnt vmcnt(0)" ::: "memory")
__device__ __forceinline__ unsigned long long rt() { return __builtin_amdgcn_s_memrealtime(); }
__device__ __forceinline__ unsigned f2bf(float f) { unsigned u = __builtin_bit_cast(unsigned, f); return (u + 0x7fffu + ((u >> 16) & 1u)) >> 16; }
__device__ __forceinline__ unsigned pk2(float lo, float hi) { return f2bf(lo) | (f2bf(hi) << 16); }

#define XB_TMO      128
#define XB_XCNT(j)  (256  + 64 * (j))
#define XB_XSUB(j)  (1280 + 64 * (j))
#define XB_XGEN(j)  (2304 + 64 * (j))
#define XB_TOP      3328
#define XB_TOPGEN   3392
#define XCD_BAR_WORDS 3456
#define XB_SPIN_CAP (1u << 18)

__device__ __forceinline__ unsigned xb_ld(unsigned* p)              { return __hip_atomic_load(p, __ATOMIC_RELAXED, __HIP_MEMORY_SCOPE_AGENT); }
__device__ __forceinline__ unsigned xb_add(unsigned* p, unsigned v) { return __hip_atomic_fetch_add(p, v, __ATOMIC_RELAXED, __HIP_MEMORY_SCOPE_AGENT); }
__device__ __forceinline__ unsigned xb_xcc_id() { return (unsigned)__builtin_amdgcn_s_getreg((3 << 11) | 20) & 0xFu; }
#define XB_SPIN(cond, bar) do { unsigned _sp = 0; while (cond) { __builtin_amdgcn_s_sleep(1); \
    if ((++_sp & 255u) == 0u) { if (xb_ld(&(bar)[XB_TMO])) break; if (_sp > XB_SPIN_CAP) { atomicAdd(&(bar)[XB_TMO], 1u); break; } } } } while (0)

struct XcdBarrier {
    unsigned* bar; unsigned x;
    volatile LAS unsigned* st;
};

__device__ __forceinline__ XcdBarrier xcd_barrier_post(unsigned* bar, volatile LAS unsigned* st) {
    XcdBarrier b; b.bar = bar; b.x = xb_xcc_id(); b.st = st;
    if (threadIdx.x == 0) (void)xb_add(&bar[XB_XCNT(b.x)], 1u);
    return b;
}
__device__ __forceinline__ void xcd_barrier_complete(unsigned* bar, unsigned x, unsigned& nloc, unsigned& nx) {
    const unsigned G = gridDim.x * gridDim.y * gridDim.z;
    unsigned sum, cnt, mine, sp = 0u;
    for (;;) {
        sum = 0u; cnt = 0u; mine = 0u;
#pragma unroll
        for (unsigned j = 0; j < 16; ++j) { const unsigned c = xb_ld(&bar[XB_XCNT(j)]); sum += c; cnt += (c > 0u) ? 1u : 0u; mine = (j == x) ? c : mine; }
        if (sum == G) break;
        __builtin_amdgcn_s_sleep(1);
        if ((++sp & 255u) == 0u) { if (xb_ld(&bar[XB_TMO])) break; if (sp > XB_SPIN_CAP) { atomicAdd(&bar[XB_TMO], 1u); break; } }
    }
    nloc = mine > 0u ? mine : 1u; nx = cnt > 0u ? cnt : 1u;
}

__device__ __forceinline__ void xcd_barrier(const XcdBarrier& b) {
    asm volatile("s_waitcnt vmcnt(0)" ::: "memory");
    __syncthreads();
    if (threadIdx.x == 0) {
        unsigned* bar = b.bar;
        __builtin_amdgcn_s_waitcnt(0);
        unsigned nloc = b.st[0], nx = b.st[1];
        if (nloc == 0u) { xcd_barrier_complete(bar, b.x, nloc, nx); b.st[0] = nloc; b.st[1] = nx; }
        const unsigned old = xb_add(&bar[XB_XSUB(b.x)], 1u);
        const unsigned gen = old / nloc;
        if (old + 1u == (gen + 1u) * nloc) {
            __builtin_amdgcn_fence(__ATOMIC_RELEASE, "agent");
            asm volatile("s_waitcnt vmcnt(0)" ::: "memory");
            const unsigned og = xb_add(&bar[XB_TOP], 1u);
            const unsigned tg = og / nx;
            if (og + 1u == (tg + 1u) * nx) xb_add(&bar[XB_TOPGEN], 1u);
            else XB_SPIN(xb_ld(&bar[XB_TOPGEN]) == tg, bar);
            __builtin_amdgcn_fence(__ATOMIC_ACQUIRE, "agent");
            xb_add(&bar[XB_XGEN(b.x)], 1u);
            asm volatile("s_waitcnt vmcnt(0)" ::: "memory");
        } else {
            XB_SPIN(xb_ld(&bar[XB_XGEN(b.x)]) == gen, bar);
            __builtin_amdgcn_fence(__ATOMIC_ACQUIRE, "agent");
            asm volatile("s_waitcnt vmcnt(0)" ::: "memory");
        }
    }
    __syncthreads();
}

typedef float f32x2 __attribute__((ext_vector_type(2)));
constexpr int NWAVES = 8;
#ifndef MK_N_LAUNCHES
#define MK_N_LAUNCHES 1
#endif
constexpr int NPH = 12;
constexpr int DM = 2048, NCTX = 4096, NLAT = 16384, MROWS = 20480, IN0 = 5632, IN1 = 6656;
constexpr float EPS = 1e-6f, LOG2E = 1.4426950408889634f;
constexpr float QSCALE = 0.08838834764831845f * LOG2E;

constexpr size_t MiB = 1u << 20;
constexpr size_t WS_CTL = 0, CTL_ZERO_BYTES = 1 * MiB;
constexpr size_t WS_WIN0 = 2 * MiB, WS_WOUT0 = 24 * MiB, WS_WIN1 = 32 * MiB, WS_WOUT1 = 58 * MiB;
constexpr size_t WS_MOD = 66 * MiB;
constexpr size_t WS_ROPE = 67 * MiB;
constexpr size_t WS_KL0 = 72 * MiB, WS_VL0 = 82 * MiB, WS_KL1 = 92 * MiB, WS_VL1 = 102 * MiB;
constexpr size_t WS_KC = 112 * MiB, WS_VC = 114 * MiB;
constexpr size_t WS_H = 116 * MiB;
constexpr size_t WS_QP = 196 * MiB;
constexpr size_t WS_PROJ = 236 * MiB;
constexpr size_t WS_END = 496 * MiB;
constexpr int CW_BAR = 4096;
constexpr size_t OUT_K0 = (size_t)MROWS * DM, OUT_V0 = OUT_K0 + 1048576, OUT_K1 = OUT_K0 + 2 * 1048576, OUT_V1 = OUT_K0 + 3 * 1048576;

constexpr int RING_BYTES = 131072, LDSCTL_OFF = RING_BYTES, MISC_OFF = LDSCTL_OFF + 320, LDS_BYTES = 147456;

struct Args { const float* in[27]; float* out; unsigned char* ws; int ph_lo, ph_hi; };

struct Frame {
    LAS unsigned char* lds;
    volatile LAS unsigned* MISC;
    int tid, lane, wave, vcu, G;
};

__device__ __forceinline__ float bf_lo(unsigned u) { return __uint_as_float(u << 16); }
__device__ __forceinline__ float bf_hi(unsigned u) { return __uint_as_float(u & 0xffff0000u); }
__device__ __forceinline__ float sigmoidf_(float x) { return 1.0f / (1.0f + __expf(-x)); }
__device__ __forceinline__ float siluf_(float x) { return x / (1.0f + __expf(-x)); }
__device__ __forceinline__ float wave_sum(float v) {
#pragma unroll
    for (int o = 1; o < 64; o <<= 1) v += __shfl_xor(v, o);
    return v;
}

__device__ __forceinline__ void p0_transpose_item(const float* W, int K, int N, bf16* WT, LAS float* scr, int item, int lane) {
    const int nblk = N / 32, kb = item / nblk, nb = item % nblk, k0 = 64 * kb, n0 = 32 * nb;
#pragma unroll 8
    for (int i = 0; i < 32; ++i) { const int kk = 2 * i + (lane >> 5); scr[kk * 33 + (lane & 31)] = W[(size_t)(k0 + kk) * N + n0 + (lane & 31)]; }
    LDS_WAIT(); asm volatile("" ::: "memory");
    const int c = lane & 7;
#pragma unroll
    for (int j = 0; j < 4; ++j) { const int n = (lane >> 3) + 8 * j; const LAS float* s = scr + (8 * c) * 33 + n;
        v4u o; o.x = pk2(s[0 * 33], s[1 * 33]); o.y = pk2(s[2 * 33], s[3 * 33]); o.z = pk2(s[4 * 33], s[5 * 33]); o.w = pk2(s[6 * 33], s[7 * 33]);
        *(GAS v4u*)(WT + (size_t)(n0 + n) * K + k0 + 8 * c) = o; }
    LDS_WAIT(); asm volatile("" ::: "memory");
}

__device__ __forceinline__ void p0_prologue(Frame& F, const Args& a) {
    unsigned char* ws = a.ws;
    float* MOD = (float*)(ws + WS_MOD);
    {
        LAS float* red = (LAS float*)F.lds;
        for (int it = blockIdx.x; it < 192; it += F.G) {
            const int l = it / 96, cg = it % 96, n = cg * 64 + F.lane, kb = F.wave * 256;
            const float* W = a.in[l ? 19 : 8]; const float* bias = a.in[l ? 20 : 9];
            float cs[9][4];
#pragma unroll
            for (int r = 0; r < 9; ++r)
#pragma unroll
                for (int j = 0; j < 4; ++j) { const int k = kb + 64 * j + F.lane; const float x = (r < 8) ? a.in[6][r * DM + k] : a.in[7][k]; cs[r][j] = x / (1.0f + expf(-x)); }
            float acc[9];
#pragma unroll
            for (int r = 0; r < 9; ++r) acc[r] = 0.f;
#pragma unroll
            for (int j = 0; j < 4; ++j) {
#pragma unroll 8
                for (int kk = 0; kk < 64; ++kk) {
                    const float w = W[(size_t)(kb + 64 * j + kk) * 6144 + n];
#pragma unroll
                    for (int r = 0; r < 9; ++r) acc[r] += __int_as_float(__builtin_amdgcn_readlane(__float_as_int(cs[r][j]), kk)) * w;
                }
            }
#pragma unroll
            for (int r = 0; r < 9; ++r) red[(F.wave * 9 + r) * 64 + F.lane] = acc[r];
            __syncthreads();
            for (int idx = F.tid; idx < 576; idx += 512) { const int r = idx >> 6, ln = idx & 63; float s = 0.f;
#pragma unroll
                for (int w = 0; w < 8; ++w) s += red[(w * 9 + r) * 64 + ln];
                MOD[(size_t)(l * 9 + r) * 6144 + cg * 64 + ln] = s + bias[cg * 64 + ln]; }
            __syncthreads();
        }
    }
    LAS float* scr = (LAS float*)(F.lds + F.wave * 16384);
    const int gw = F.vcu * NWAVES + F.wave, NGW = F.G * NWAVES;
    constexpr int I_IN0 = 32 * (IN0 / 32), I_OUT = 32 * (DM / 32), I_IN1 = 32 * (IN1 / 32), I_T = I_IN0 + I_OUT + I_IN1 + I_OUT, I_C = 4 * 2048, I_R = 32;
    for (int it = gw; it < I_T + I_C + I_R; it += NGW) {
        int r = it;
        if (r < I_IN0) { p0_transpose_item(a.in[11], DM, IN0, (bf16*)(ws + WS_WIN0), scr, r, F.lane); continue; } r -= I_IN0;
        if (r < I_OUT) { p0_transpose_item(a.in[18], DM, DM, (bf16*)(ws + WS_WOUT0), scr, r, F.lane); continue; } r -= I_OUT;
        if (r < I_IN1) { p0_transpose_item(a.in[22], DM, IN1, (bf16*)(ws + WS_WIN1), scr, r, F.lane); continue; } r -= I_IN1;
        if (r < I_OUT) { p0_transpose_item(a.in[25], DM, DM, (bf16*)(ws + WS_WOUT1), scr, r, F.lane); continue; } r -= I_OUT;
        if (r < I_C) {
            const int ts = r >> 11, wi = r & 2047, e0 = wi * 512 + F.lane * 8;
            const float* src = a.in[2 + ts] + e0;
            const f32x4 v0 = *(const f32x4*)src, v1 = *(const f32x4*)(src + 4);
            bf16* dst = (bf16*)(ws + (ts == 0 ? WS_KL0 : ts == 1 ? WS_VL0 : ts == 2 ? WS_KL1 : WS_VL1)) + (size_t)(e0 >> 17) * (2560 * 256) + (e0 & 131071);
            v4u o; o.x = pk2(v0[0], v0[1]); o.y = pk2(v0[2], v0[3]); o.z = pk2(v1[0], v1[1]); o.w = pk2(v1[2], v1[3]);
            *(v4u*)dst = o; continue; }
        r -= I_C;
        {
            const int idx = r * 64 + F.lane, pos = idx >> 5, j = idx & 31;
            const float inv = exp2f(-(float)j * (13.287712379549449f / 32.0f));
            double rev = (double)pos * (double)inv * 0.15915494309189535; rev -= floor(rev);
            float* T = (float*)(ws + WS_ROPE) + idx * 2;
            T[0] = __builtin_amdgcn_cosf((float)rev); T[1] = __builtin_amdgcn_sinf((float)rev);
        }
    }
}

__device__ __forceinline__ void h_rows(Frame& F, const Args& a, int layer, const float* xp, const float* xs, const float* g) {
    const float* MOD = (const float*)(a.ws + WS_MOD); bf16* H = (bf16*)(a.ws + WS_H);
    const int gw = F.vcu * NWAVES + F.wave, NGW = F.G * NWAVES;
    for (int row = gw; row < MROWS; row += NGW) {
        const float* src = row < NCTX ? xp + (size_t)row * DM : xs + (size_t)(row - NCTX) * DM;
        const int cr = row < NCTX ? 8 : ((row - NCTX) >> 11);
        const float* mod = MOD + (size_t)(layer * 9 + cr) * 6144;
        f32x4 v[8]; float ss = 0.f;
#pragma unroll
        for (int j = 0; j < 8; ++j) { v[j] = *(const f32x4*)(src + j * 256 + F.lane * 4); ss += (v[j][0] * v[j][0] + v[j][1] * v[j][1]) + (v[j][2] * v[j][2] + v[j][3] * v[j][3]); }
        const float rstd = 1.0f / sqrtf(wave_sum(ss) * (1.0f / DM) + EPS);
#pragma unroll
        for (int j = 0; j < 8; ++j) { const int c = j * 256 + F.lane * 4;
            const f32x4 gg = *(const f32x4*)(g + c), sh = *(const f32x4*)(mod + c), sc = *(const f32x4*)(mod + 2048 + c);
            const f32x4 y = (v[j] * rstd) * gg; const f32x4 h = y * (sc + 1.0f) + sh;
            unsigned long long o = (unsigned long long)pk2(h[0], h[1]) | ((unsigned long long)pk2(h[2], h[3]) << 32);
            *(unsigned long long*)(H + (size_t)row * DM + c) = o; }
    }
}

__device__ __forceinline__ void final_rows(Frame& F, const Args& a) {
    const float* g = a.in[26];
    const int gw = F.vcu * NWAVES + F.wave, NGW = F.G * NWAVES;
    for (int row = gw; row < MROWS; row += NGW) {
        float* p = a.out + (size_t)row * DM;
        f32x4 v[8]; float ss = 0.f;
#pragma unroll
        for (int j = 0; j < 8; ++j) { v[j] = *(const f32x4*)(p + j * 256 + F.lane * 4); ss += (v[j][0] * v[j][0] + v[j][1] * v[j][1]) + (v[j][2] * v[j][2] + v[j][3] * v[j][3]); }
        const float rstd = 1.0f / sqrtf(wave_sum(ss) * (1.0f / DM) + EPS);
#pragma unroll
        for (int j = 0; j < 8; ++j) { const int c = j * 256 + F.lane * 4; const f32x4 gg = *(const f32x4*)(g + c); *(f32x4*)(p + c) = (v[j] * rstd) * gg; }
    }
}

template <int R> struct ConvStep {
    static __device__ __forceinline__ void run(f32x2 (&out)[32], const f32x2 (&w)[31], const bf16* P, int rowbase, int S, int t0, int tid) {
        const int t = t0 - 15 + R; const bool valid = (t >= 0) && (t < S); const int tc = t < 0 ? 0 : (t >= S ? S - 1 : t);
        const bf16* pr = P + (size_t)(rowbase + tc) * IN0 + 2 * tid;
        const unsigned ga = *(const unsigned*)pr, gb = *(const unsigned*)(pr + 1024);
        f32x2 av; av.x = bf_lo(ga) * sigmoidf_(bf_lo(gb)); av.y = bf_hi(ga) * sigmoidf_(bf_hi(gb));
        if (!valid) { av.x = 0.f; av.y = 0.f; }
#pragma unroll
        for (int j = 0; j < 31; ++j) { const int tp = R - j; if (tp >= 0 && tp < 32) out[tp] += w[j] * av; }
        ConvStep<R + 1>::run(out, w, P, rowbase, S, t0, tid);
    }
};
template <> struct ConvStep<62> { static __device__ __forceinline__ void run(f32x2 (&)[32], const f32x2 (&)[31], const bf16*, int, int, int, int) {} };

__device__ __forceinline__ void conv0_items(Frame& F, const Args& a) {
    const bf16* P = (const bf16*)(a.ws + WS_PROJ); bf16* MIX = (bf16*)(a.ws + WS_H);
    const float* cw = a.in[12]; const float* cb = a.in[13]; const float* lng = a.in[14]; const float* lnb = a.in[15];
    LAS float* cv = (LAS float*)F.lds;
    const int tid = F.tid;
    f32x2 w[31];
#pragma unroll
    for (int j = 0; j < 31; ++j) w[j] = *(const f32x2*)(cw + j * 1024 + 2 * tid);
    const f32x2 bias = *(const f32x2*)(cb + 2 * tid);
    for (int ci = blockIdx.x; ci < 640; ci += F.G) {
        int rowbase, S, t0;
        if (ci < 128) { rowbase = (ci >> 3) * 256; S = 256; t0 = (ci & 7) * 32; } else { const int li = ci - 128; rowbase = NCTX + (li >> 6) * 2048; S = 2048; t0 = (li & 63) * 32; }
        f32x2 out[32];
#pragma unroll
        for (int i = 0; i < 32; ++i) out[i] = bias;
        ConvStep<0>::run(out, w, P, rowbase, S, t0, tid);
#pragma unroll
        for (int i = 0; i < 32; ++i) *(LAS f32x2*)(cv + i * 1024 + 2 * tid) = out[i];
        __syncthreads();
#pragma unroll 1
        for (int i = 0; i < 4; ++i) {
            const int tp = F.wave * 4 + i; const size_t row = (size_t)(rowbase + t0 + tp);
            f32x4 x[4]; float s = 0.f;
#pragma unroll
            for (int q = 0; q < 4; ++q) { x[q] = *(const LAS f32x4*)(cv + tp * 1024 + q * 256 + F.lane * 4); s += (x[q][0] + x[q][1]) + (x[q][2] + x[q][3]); }
            const float mean = wave_sum(s) * (1.0f / 1024.0f); float s2 = 0.f;
#pragma unroll
            for (int q = 0; q < 4; ++q) { x[q] = x[q] - mean; s2 += (x[q][0] * x[q][0] + x[q][1] * x[q][1]) + (x[q][2] * x[q][2] + x[q][3] * x[q][3]); }
            const float rstd = 1.0f / sqrtf(wave_sum(s2) * (1.0f / 1024.0f) + EPS);
#pragma unroll
            for (int q = 0; q < 4; ++q) { const int c = q * 256 + F.lane * 4;
                const f32x4 g4 = *(const f32x4*)(lng + c), b4 = *(const f32x4*)(lnb + c);
                const f32x4 y = (x[q] * rstd) * g4 + b4;
                const unsigned long long gt = *(const unsigned long long*)(P + row * IN0 + 2048 + c);
                const unsigned glo = (unsigned)gt, ghi = (unsigned)(gt >> 32);
                const float o0 = siluf_(y[0]) * siluf_(bf_lo(glo)), o1 = siluf_(y[1]) * siluf_(bf_hi(glo)), o2 = siluf_(y[2]) * siluf_(bf_lo(ghi)), o3 = siluf_(y[3]) * siluf_(bf_hi(ghi));
                *(unsigned long long*)(MIX + row * DM + c) = (unsigned long long)pk2(o0, o1) | ((unsigned long long)pk2(o2, o3) << 32); }
        }
        __syncthreads();
    }
}

template <int LAYER> __device__ __forceinline__ void prep_rows(Frame& F, const Args& a) {
    constexpr int ldc = LAYER ? IN1 : IN0, qoff = LAYER ? 0 : 3072, koff = LAYER ? 1024 : 4096, voff = LAYER ? 1280 : 4352;
    const bf16* P = (const bf16*)(a.ws + WS_PROJ); bf16* QP = (bf16*)(a.ws + WS_QP);
    bf16* KL = (bf16*)(a.ws + (LAYER ? WS_KL1 : WS_KL0)); bf16* VL = (bf16*)(a.ws + (LAYER ? WS_VL1 : WS_VL0));
    bf16* KC = (bf16*)(a.ws + WS_KC); bf16* VC = (bf16*)(a.ws + WS_VC);
    const float* ROPE = (const float*)(a.ws + WS_ROPE);
    const float* qg = a.in[16]; const float* kg = a.in[17];
    const int gw = F.vcu * NWAVES + F.wave, NGW = F.G * NWAVES, lane = F.lane;
    for (int row = gw; row < MROWS; row += NGW) {
        const bool lat = row >= NCTX; const int t = (row - NCTX) & 2047, b = (row - NCTX) >> 11, trow = t >> 6, tcol = t & 63;
        const bf16* pr = P + (size_t)row * ldc;
#pragma unroll
        for (int pass = 0; pass < 2; ++pass) {
            const int li = pass ? (lane & 15) : lane, c = li & 7;
            const bf16* src = pr + (pass ? koff : qoff) + li * 16;
            const v4u r0 = *(const v4u*)src, r1 = *(const v4u*)(src + 8);
            float x[16];
            x[0] = bf_lo(r0.x); x[1] = bf_hi(r0.x); x[2] = bf_lo(r0.y); x[3] = bf_hi(r0.y); x[4] = bf_lo(r0.z); x[5] = bf_hi(r0.z); x[6] = bf_lo(r0.w); x[7] = bf_hi(r0.w);
            x[8] = bf_lo(r1.x); x[9] = bf_hi(r1.x); x[10] = bf_lo(r1.y); x[11] = bf_hi(r1.y); x[12] = bf_lo(r1.z); x[13] = bf_hi(r1.z); x[14] = bf_lo(r1.w); x[15] = bf_hi(r1.w);
            if (LAYER == 0) {
                float ss = 0.f;
#pragma unroll
                for (int e = 0; e < 16; ++e) ss += x[e] * x[e];
                ss += __shfl_xor(ss, 1); ss += __shfl_xor(ss, 2); ss += __shfl_xor(ss, 4);
                const float rstd = 1.0f / sqrtf(ss * (1.0f / 128.0f) + EPS);
                const float* gp = (pass ? kg : qg) + c * 16;
#pragma unroll
                for (int e = 0; e < 16; ++e) x[e] = (x[e] * rstd) * gp[e];
            }
            if (lat) {
                const int cc = c & 3, pos = (c < 4) ? trow : tcol; const bool first = cc < 2;
                const float* tb = ROPE + (size_t)(pos * 32 + 16 * (cc & 1)) * 2;
#pragma unroll
                for (int e = 0; e < 16; ++e) { const float pv = __shfl_xor(x[e], 2); const float cs = tb[2 * e], sn = tb[2 * e + 1]; x[e] = first ? (x[e] * cs - pv * sn) : (x[e] * cs + pv * sn); }
            }
            if (pass == 0) {
                v4u o0, o1;
                o0.x = pk2(x[0] * QSCALE, x[1] * QSCALE); o0.y = pk2(x[2] * QSCALE, x[3] * QSCALE); o0.z = pk2(x[4] * QSCALE, x[5] * QSCALE); o0.w = pk2(x[6] * QSCALE, x[7] * QSCALE);
                o1.x = pk2(x[8] * QSCALE, x[9] * QSCALE); o1.y = pk2(x[10] * QSCALE, x[11] * QSCALE); o1.z = pk2(x[12] * QSCALE, x[13] * QSCALE); o1.w = pk2(x[14] * QSCALE, x[15] * QSCALE);
                bf16* dst = QP + (size_t)row * 1024 + lane * 16; *(v4u*)dst = o0; *(v4u*)(dst + 8) = o1;
            } else if (lane < 16) {
                v4u o0, o1;
                o0.x = pk2(x[0], x[1]); o0.y = pk2(x[2], x[3]); o0.z = pk2(x[4], x[5]); o0.w = pk2(x[6], x[7]);
                o1.x = pk2(x[8], x[9]); o1.y = pk2(x[10], x[11]); o1.z = pk2(x[12], x[13]); o1.w = pk2(x[14], x[15]);
                bf16* dst = lat ? KL + ((size_t)b * 2560 + 512 + t) * 256 + lane * 16 : KC + (size_t)row * 256 + lane * 16;
                *(v4u*)dst = o0; *(v4u*)(dst + 8) = o1;
                if (LAYER == 0 && !lat) { float* ko = a.out + OUT_K0 + (size_t)row * 256 + lane * 16;
#pragma unroll
                    for (int e = 0; e < 16; e += 4) *(f32x4*)(ko + e) = (f32x4){x[e], x[e + 1], x[e + 2], x[e + 3]}; }
            }
        }
        if (lane >= 32) {
            const int vl = lane - 32; const v4u vv = *(const v4u*)(pr + voff + vl * 8);
            bf16* dst = lat ? VL + ((size_t)b * 2560 + 512 + t) * 256 + vl * 8 : VC + (size_t)row * 256 + vl * 8;
            *(v4u*)dst = vv;
        }
    }
}

__device__ __forceinline__ void conv1_rows(Frame& F, const Args& a) {
    const bf16* P = (const bf16*)(a.ws + WS_PROJ); bf16* MIX = (bf16*)(a.ws + WS_H); const float* sw = a.in[24];
    const int gw = F.vcu * NWAVES + F.wave, NGW = F.G * NWAVES;
    for (int it = gw; it < MROWS * 2; it += NGW) {
        const int row = it >> 1, c0 = (it & 1) * 512 + F.lane * 8;
        int t, S; if (row < NCTX) { t = row & 255; S = 256; } else { t = (row - NCTX) & 2047; S = 2048; }
        const bf16* pr = P + (size_t)row * IN1;
        float cvv[8];
#pragma unroll
        for (int e = 0; e < 8; ++e) cvv[e] = 0.f;
#pragma unroll
        for (int j = 0; j < 3; ++j) {
            const int tt = t + j - 1;
            if (tt >= 0 && tt < S) {
                const bf16* pq = pr + (ptrdiff_t)(j - 1) * IN1;
                const v4u dc = *(const v4u*)(pq + 3584 + c0), dx = *(const v4u*)(pq + 4608 + c0);
                const f32x4 w0 = *(const f32x4*)(sw + j * 1024 + c0), w1 = *(const f32x4*)(sw + j * 1024 + c0 + 4);
                cvv[0] += w0[0] * (bf_lo(dc.x) * bf_lo(dx.x)); cvv[1] += w0[1] * (bf_hi(dc.x) * bf_hi(dx.x));
                cvv[2] += w0[2] * (bf_lo(dc.y) * bf_lo(dx.y)); cvv[3] += w0[3] * (bf_hi(dc.y) * bf_hi(dx.y));
                cvv[4] += w1[0] * (bf_lo(dc.z) * bf_lo(dx.z)); cvv[5] += w1[1] * (bf_hi(dc.z) * bf_hi(dx.z));
                cvv[6] += w1[2] * (bf_lo(dc.w) * bf_lo(dx.w)); cvv[7] += w1[3] * (bf_hi(dc.w) * bf_hi(dx.w));
            }
        }
        const v4u db = *(const v4u*)(pr + 2560 + c0), gd = *(const v4u*)(pr + 5632 + c0);
        v4u o;
        o.x = pk2(bf_lo(db.x) * cvv[0] * siluf_(bf_lo(gd.x)), bf_hi(db.x) * cvv[1] * siluf_(bf_hi(gd.x)));
        o.y = pk2(bf_lo(db.y) * cvv[2] * siluf_(bf_lo(gd.y)), bf_hi(db.y) * cvv[3] * siluf_(bf_hi(gd.y)));
        o.z = pk2(bf_lo(db.z) * cvv[4] * siluf_(bf_lo(gd.z)), bf_hi(db.z) * cvv[5] * siluf_(bf_hi(gd.z)));
        o.w = pk2(bf_lo(db.w) * cvv[6] * siluf_(bf_lo(gd.w)), bf_hi(db.w) * cvv[7] * siluf_(bf_hi(gd.w)));
        *(v4u*)(MIX + (size_t)row * DM + 1024 + c0) = o;
    }
}

template <int LAYER> __device__ __forceinline__ void attn_simple(Frame& F, const Args& a) {
    constexpr int ldc = LAYER ? IN1 : IN0, goff = LAYER ? 1536 : 4608, ocol = LAYER ? 0 : 1024;
    const bf16* P = (const bf16*)(a.ws + WS_PROJ); const bf16* QP = (const bf16*)(a.ws + WS_QP); bf16* MIX = (bf16*)(a.ws + WS_H);
    const bf16* KL = (const bf16*)(a.ws + (LAYER ? WS_KL1 : WS_KL0)); const bf16* VL = (const bf16*)(a.ws + (LAYER ? WS_VL1 : WS_VL0));
    const bf16* KC = (const bf16*)(a.ws + WS_KC); const bf16* VC = (const bf16*)(a.ws + WS_VC);
    const float* sink = a.in[23];
    const int gw = F.vcu * NWAVES + F.wave, NGW = F.G * NWAVES, lane = F.lane;
    for (int it = gw; it < MROWS * 8; it += NGW) {
        const int row = it >> 3, h = it & 7, kvh = h >> 2;
        const unsigned qq = *(const unsigned*)(QP + (size_t)row * 1024 + h * 128 + 2 * lane);
        const float q0 = bf_lo(qq), q1 = bf_hi(qq);
        const bf16* Kb; const bf16* Vb; int nA, b0, b1;
        if (row < NCTX) { const size_t o = (size_t)(row >> 8) * 65536 + kvh * 128 + 2 * lane; Kb = KC + o; Vb = VC + o; nA = 256; b0 = 0; b1 = 0; }
        else { const int t = (row - NCTX) & 2047, b = (row - NCTX) >> 11; const size_t o = (size_t)b * (2560 * 256) + kvh * 128 + 2 * lane; Kb = KL + o; Vb = VL + o;
            if (LAYER == 0) { nA = 2560; b0 = 0; b1 = 0; } else { nA = 512; b0 = 512 + (t > 128 ? t - 128 : 0); b1 = 512 + (t + 128 < 2047 ? t + 128 : 2047) + 1; } }
        float m, l, o0 = 0.f, o1 = 0.f;
        if (LAYER) { m = sink[h] * LOG2E; l = 1.f; } else { m = -1e30f; l = 0.f; }
#pragma unroll 1
        for (int rg = 0; rg < 2; ++rg) {
            const int js = rg ? b0 : 0, je = rg ? b1 : nA;
#pragma unroll 1
            for (int j = js; j < je; j += 4) {
                float s[4]; unsigned vv[4];
#pragma unroll
                for (int u = 0; u < 4; ++u) { const int jj = (j + u < je) ? j + u : je - 1; const unsigned kk = *(const unsigned*)(Kb + (size_t)jj * 256); vv[u] = *(const unsigned*)(Vb + (size_t)jj * 256); s[u] = q0 * bf_lo(kk) + q1 * bf_hi(kk); }
#pragma unroll
                for (int off = 1; off < 64; off <<= 1)
#pragma unroll
                    for (int u = 0; u < 4; ++u) s[u] += __shfl_xor(s[u], off);
#pragma unroll
                for (int u = 0; u < 4; ++u) if (j + u >= je) s[u] = -1e30f;
                const float mn = fmaxf(fmaxf(m, fmaxf(s[0], s[1])), fmaxf(s[2], s[3]));
                const float al = exp2f(m - mn);
                const float p0 = exp2f(s[0] - mn), p1 = exp2f(s[1] - mn), p2 = exp2f(s[2] - mn), p3 = exp2f(s[3] - mn);
                l = l * al + ((p0 + p1) + (p2 + p3));
                o0 = o0 * al + ((p0 * bf_lo(vv[0]) + p1 * bf_lo(vv[1])) + (p2 * bf_lo(vv[2]) + p3 * bf_lo(vv[3])));
                o1 = o1 * al + ((p0 * bf_hi(vv[0]) + p1 * bf_hi(vv[1])) + (p2 * bf_hi(vv[2]) + p3 * bf_hi(vv[3])));
                m = mn;
            }
        }
        const float inv = 1.0f / l;
        const unsigned gt = *(const unsigned*)(P + (size_t)row * ldc + goff + h * 128 + 2 * lane);
        *(unsigned*)(MIX + (size_t)row * DM + ocol + h * 128 + 2 * lane) = pk2(o0 * inv * siluf_(bf_lo(gt)), o1 * inv * siluf_(bf_hi(gt)));
    }
}

__global__ void __launch_bounds__(NWAVES * 64, 2) mk_fwd(Args args) {
    extern __shared__ __attribute__((aligned(16))) unsigned char lds[];
    Frame F;
    F.lds = (LAS unsigned char*)lds;
    F.MISC = (volatile LAS unsigned*)(F.lds + MISC_OFF);
    F.tid = threadIdx.x; F.lane = F.tid & 63; F.wave = __builtin_amdgcn_readfirstlane(F.tid >> 6);
    F.G = gridDim.x; { const int bx = blockIdx.x; F.vcu = (F.G % 8 == 0) ? (bx % 8) * (F.G / 8) + bx / 8 : bx; }
    unsigned char* ws = args.ws;
    gu32* ctl = (gu32*)(ws + WS_CTL);
    for (int u = F.tid; u < (LDS_BYTES - LDSCTL_OFF) / 4; u += NWAVES * 64) ((LAS unsigned*)(F.lds + LDSCTL_OFF))[u] = 0u;
    __syncthreads();
    const int lo = args.ph_lo, hi = args.ph_hi;
    XcdBarrier bar; bar.bar = (unsigned*)(ctl + CW_BAR); bar.x = 0; bar.st = nullptr;
    if (hi - lo > 1) bar = xcd_barrier_post((unsigned*)(ctl + CW_BAR), F.MISC + 8);
#define IN(k) (lo <= (k) && (k) < hi)
#define SEAM(k) do { if (IN(k) && IN((k) + 1)) xcd_barrier(bar); } while (0)
    bf16* Hb = (bf16*)(ws + WS_H); bf16* PROJ = (bf16*)(ws + WS_PROJ);
    const float* MOD = (const float*)(ws + WS_MOD);

    if (IN(0)) { p0_prologue(F, args); } SEAM(0);
    if (IN(1)) { h_rows(F, args, 0, args.in[0], args.in[1], args.in[10]); } SEAM(1);
    if (IN(2)) {
        pg8::Gemm g{Hb, (const bf16*)(ws + WS_WIN0), MROWS, IN0, DM}; pg8::StaticOrder S; S.init(MROWS, IN0, F.G, (int)blockIdx.x);
        pg8::EpiProj E{PROJ, IN0, 17, args.out + OUT_V0, -1, nullptr};
        pg8::gemm_phase<pg8::EpiProj, pg8::StaticOrder, true, true>(F.lds, g, S, E);
    } SEAM(2);
    if (IN(3)) { conv0_items(F, args); prep_rows<0>(F, args); } SEAM(3);
    if (IN(4)) { attn_simple<0>(F, args); } SEAM(4);
    if (IN(5)) {
        pg8::Gemm g{Hb, (const bf16*)(ws + WS_WOUT0), MROWS, DM, DM}; pg8::StaticOrder S; S.init(MROWS, DM, F.G, (int)blockIdx.x);
        pg8::EpiRes E{args.in[0], args.in[1], args.out, MOD + 4096};
        pg8::gemm_phase<pg8::EpiRes, pg8::StaticOrder, true, true>(F.lds, g, S, E);
    } SEAM(5);
    if (IN(6)) { h_rows(F, args, 1, args.out, args.out + (size_t)NCTX * DM, args.in[21]); } SEAM(6);
    if (IN(7)) {
        pg8::Gemm g{Hb, (const bf16*)(ws + WS_WIN1), MROWS, IN1, DM}; pg8::StaticOrder S; S.init(MROWS, IN1, F.G, (int)blockIdx.x);
        pg8::EpiProj E{PROJ, IN1, 4, args.out + OUT_K1, 5, args.out + OUT_V1};
        pg8::gemm_phase<pg8::EpiProj, pg8::StaticOrder, true, true>(F.lds, g, S, E);
    } SEAM(7);
    if (IN(8)) { conv1_rows(F, args); prep_rows<1>(F, args); } SEAM(8);
    if (IN(9)) { attn_simple<1>(F, args); } SEAM(9);
    if (IN(10)) {
        pg8::Gemm g{Hb, (const bf16*)(ws + WS_WOUT1), MROWS, DM, DM}; pg8::StaticOrder S; S.init(MROWS, DM, F.G, (int)blockIdx.x);
        pg8::EpiRes E{args.out, args.out + (size_t)NCTX * DM, args.out, MOD + 9 * 6144 + 4096};
        pg8::gemm_phase<pg8::EpiRes, pg8::StaticOrder, true, true>(F.lds, g, S, E);
    } SEAM(10);
    if (IN(11)) { final_rows(F, args); }
#undef IN
#undef SEAM
}

extern "C" void kernel_launch(void* const* d_in, const int* in_sizes, int n_in, void* d_out, int out_size, void* d_ws, size_t ws_size, hipStream_t stream) {
    static int grid = 0;
    if (grid == 0) {
        if (n_in != 27 || out_size != (int)(OUT_K0 + 4 * 1048576) || ws_size < WS_END) { fprintf(stderr, "kernel_launch: unexpected problem shape: n_in %d out %d ws %zu; nothing launched\n", n_in, out_size, ws_size); grid = -1; return; }
        int dev = 0, cus = 0;
        if (hipGetDevice(&dev) != hipSuccess || hipDeviceGetAttribute(&cus, hipDeviceAttributeMultiprocessorCount, dev) != hipSuccess) { grid = -1; return; }
        if (hipFuncSetAttribute((const void*)mk_fwd, hipFuncAttributeMaxDynamicSharedMemorySize, LDS_BYTES) != hipSuccess) { fprintf(stderr, "kernel_launch: hipFuncSetAttribute failed\n"); grid = -1; return; }
        int per_cu = 0;
        if (hipOccupancyMaxActiveBlocksPerMultiprocessor(&per_cu, (const void*)mk_fwd, NWAVES * 64, LDS_BYTES) != hipSuccess || per_cu < 1) fprintf(stderr, "kernel_launch: note: occupancy query reports %d workgroups per CU\n", per_cu);
        (void)hipGetLastError();
        grid = cus;
    }
    if (grid < 0) return;
    if (hipMemsetAsync((char*)d_ws + WS_CTL, 0, CTL_ZERO_BYTES, stream) != hipSuccess) { fprintf(stderr, "kernel_launch: hipMemsetAsync failed\n"); return; }
    Args a{};
    for (int i = 0; i < 27; ++i) a.in[i] = (const float*)d_in[i];
    a.out = (float*)d_out; a.ws = (unsigned char*)d_ws;
#if MK_N_LAUNCHES == 1
    a.ph_lo = 0; a.ph_hi = NPH;
    hipLaunchKernelGGL(mk_fwd, dim3(grid), dim3(NWAVES * 64), LDS_BYTES, stream, a);
#else
    for (int p = 0; p < NPH; ++p) { a.ph_lo = p; a.ph_hi = p + 1; hipLaunchKernelGGL(mk_fwd, dim3(grid), dim3(NWAVES * 64), LDS_BYTES, stream, a); }
#endif
    const hipError_t le = hipPeekAtLastError();
    if (le != hipSuccess) fprintf(stderr, "kernel_launch: launch failed: %s\n", hipGetErrorName(le));
}
```

```cpp
#include <hip/hip_runtime.h>
#include <cstdio>
#include <cstdint>
namespace pg8 {
#define PG8_LAS __attribute__((address_space(3)))
typedef unsigned short bf16_t;
typedef short bf16x8 __attribute__((ext_vector_type(8)));
typedef float f32x4 __attribute__((ext_vector_type(4)));
typedef unsigned u32x4 __attribute__((ext_vector_type(4)));
constexpr int BM = 256, BK = 64, HALF = 128, HTB = HALF * BK * 2  , STAGE_BYTES = 8 * HTB, NXCD = 8, WGM = 8;

__host__ __device__ __forceinline__ int lds_byte(int r, int c) { const int st = (r >> 4) * 2 + (c >> 5), rr = r & 15, cc = c & 31, ob = rr * 64 + cc * 2; return st * 1024 + (ob ^ (((ob >> 9) & 1) << 5)); }
__host__ __device__ __forceinline__ void stage_rc(int b, int& R, int& C) { const int st = b / 1024, sb = b % 1024, swz = sb ^ (((sb >> 9) & 1) << 5); R = (st >> 1) * 16 + swz / 64; C = (st & 1) * 32 + (swz % 64) / 2; }
__host__ __device__ __forceinline__ int perm32(int rho) { const int n = rho >> 4, i = rho & 15; return 8 * (i >> 2) + 4 * n + (i & 3); }

struct Unit { int pm, pn; };
struct Gemm { const bf16_t* A; const bf16_t* Bt; int M, N, K; };

struct StaticOrder {
    int nM, nN, nwg, G, c;
    __host__ __device__ void init(int M, int N, int G_, int c_) { nM = M / BM; nN = N / BM; nwg = nM * nN; G = G_; c = c_; }
    __host__ __device__ bool next(int i, Unit& u) const {
        const long L = (long)i * G + c; if (L >= nwg) return false;
        int wgid = (int)L; { const int q = nwg / NXCD, r = nwg % NXCD, xcd = wgid % NXCD, off = wgid / NXCD; wgid = (xcd < r ? xcd * (q + 1) : r * (q + 1) + (xcd - r) * q) + off; }
        const int nig = WGM * nN, gid = wgid / nig, fm = gid * WGM, gsz = (nM - fm) < WGM ? (nM - fm) : WGM;
        u.pm = fm + ((wgid % nig) % gsz); u.pn = (wgid % nig) / gsz; return true;
    }
    __device__ __forceinline__ void a_ready(const Unit&) const {}
    __device__ __forceinline__ void done(const Unit&) const {}
};

__device__ __forceinline__ unsigned cvt_pk_bf16(float lo, float hi) { unsigned r; asm volatile("v_cvt_pk_bf16_f32 %0, %1, %2" : "=v"(r) : "v"(lo), "v"(hi)); return r; }
typedef float f32x2 __attribute__((ext_vector_type(2)));
struct EpiProj {
    static constexpr bool PERM = true, AFTER_DRAIN = false;
    bf16_t* O; int ldc; int pn_a; float* out_a; int pn_b; float* out_b;
    __device__ __forceinline__ void operator()(const f32x4 (&acc)[2][2][4][2], const Unit& u, int wr, int wc, int fr, int fq) const {
        const int row0 = u.pm * BM + wr * 64 + fr, col0 = u.pn * BM + wc * 32 + 8 * fq;
#pragma unroll
        for (int ai = 0; ai < 2; ++ai)
#pragma unroll
            for (int m = 0; m < 4; ++m) { bf16_t* rowp = O + (size_t)(row0 + ai * HALF + m * 16) * ldc + col0;
#pragma unroll
                for (int bj = 0; bj < 2; ++bj) { const f32x4 v0 = acc[ai][bj][m][0], v1 = acc[ai][bj][m][1];
                    u32x4 w; w.x = cvt_pk_bf16(v0[0], v0[1]); w.y = cvt_pk_bf16(v0[2], v0[3]); w.z = cvt_pk_bf16(v1[0], v1[1]); w.w = cvt_pk_bf16(v1[2], v1[3]);
                    *(u32x4*)(rowp + bj * HALF) = w; } }
        float* side = nullptr;
        if (u.pm < 16) { if (u.pn == pn_a) side = out_a; else if (u.pn == pn_b) side = out_b; }
        if (side) {
#pragma unroll
            for (int ai = 0; ai < 2; ++ai)
#pragma unroll
                for (int m = 0; m < 4; ++m) { float* rowp = side + (size_t)(row0 + ai * HALF + m * 16) * 256 + wc * 32 + 8 * fq;
#pragma unroll
                    for (int bj = 0; bj < 2; ++bj) { *(f32x4*)(rowp + bj * HALF) = acc[ai][bj][m][0]; *(f32x4*)(rowp + bj * HALF + 4) = acc[ai][bj][m][1]; } }
        }
    }
};
struct EpiRes {
    static constexpr bool PERM = false, AFTER_DRAIN = false;
    const float* xp; const float* xs; float* out; const float* gate;
    __device__ __forceinline__ void operator()(const f32x4 (&acc)[2][2][4][2], const Unit& u, int wr, int wc, int fr, int fq) const {
        const int row0 = u.pm * BM + wr * 64 + fr, col0 = u.pn * BM + wc * 32 + 4 * fq;
        const int cr = u.pm < 16 ? 8 : ((u.pm - 16) >> 3);
        const float* g = gate + (size_t)cr * 6144 + col0;
        f32x4 gv[2][2];
#pragma unroll
        for (int bj = 0; bj < 2; ++bj)
#pragma unroll
            for (int n = 0; n < 2; ++n) gv[bj][n] = *(const f32x4*)(g + bj * HALF + n * 16);
#pragma unroll
        for (int ai = 0; ai < 2; ++ai)
#pragma unroll
            for (int m = 0; m < 4; ++m) { const int r = row0 + ai * HALF + m * 16;
                const float* base = (u.pm < 16 ? xp + (size_t)r * 2048 : xs + (size_t)(r - 4096) * 2048) + col0;
                float* o = out + (size_t)r * 2048 + col0;
#pragma unroll
                for (int bj = 0; bj < 2; ++bj)
#pragma unroll
                    for (int n = 0; n < 2; ++n) { const f32x4 bs = *(const f32x4*)(base + bj * HALF + n * 16); *(f32x4*)(o + bj * HALF + n * 16) = bs + gv[bj][n] * acc[ai][bj][m][n]; }
                if (m & 1) asm volatile("" ::: "memory"); }
    }
};

template <class Epi, class Sched, bool ALIGN_EPI = false, bool SP2 = false>
__device__ __forceinline__ void gemm_phase(PG8_LAS unsigned char* lds, const Gemm g, const Sched& S, const Epi& E) {
    const int tid = threadIdx.x, wid = __builtin_amdgcn_readfirstlane(tid >> 6), lane = tid & 63, wr = wid >> 2, wc = wid & 3, fr = lane & 15, fq = lane >> 4;
    const int K = g.K, nt = K / BK;
    unsigned voffA[2], voffB[2];
#pragma unroll
    for (int i = 0; i < 2; ++i) { int R, C; stage_rc(tid * 16 + i * 8192, R, C); const int Rb = Epi::PERM ? ((R & ~31) + perm32(R & 31)) : R;
        voffA[i] = (unsigned)(R * K + C) * 2u; voffB[i] = (unsigned)(Rb * K + C) * 2u; }
    const size_t kstep = (size_t)(BK * 2);
    const size_t hstep = (size_t)HALF * K * 2;
    const size_t tstep = 2 * hstep;
    const unsigned ldsw = (unsigned)wid * 1024u;
    const int aoff = lds_byte(wr * 64 + fr, fq * 8), boff = lds_byte(wc * 32 + fr, fq * 8);
#define PG8_SA(b, h) (((b) * 2 + (h)) * HTB)
#define PG8_SB(b, h) ((4 + (b) * 2 + (h)) * HTB)
#define PG8_STAGE(bufoff, gbase, voff) do { _Pragma("unroll") for (int _i = 0; _i < 2; ++_i) \
        __builtin_amdgcn_global_load_lds((const unsigned*)((const char*)(gbase) + (voff)[_i]), (PG8_LAS unsigned*)(lds + (bufoff) + ldsw + _i * 8192), 16, 0, 0); } while (0)
#define PG8_LDA(dst, b, h) do { _Pragma("unroll") for (int m = 0; m < 4; ++m) _Pragma("unroll") for (int k = 0; k < 2; ++k) dst[m][k] = *(const PG8_LAS bf16x8*)(lds + PG8_SA(b, h) + aoff + m * 2048 + k * 1024); } while (0)
#define PG8_LDB(dst, b, h) do { _Pragma("unroll") for (int n = 0; n < 2; ++n) _Pragma("unroll") for (int k = 0; k < 2; ++k) dst[n][k] = *(const PG8_LAS bf16x8*)(lds + PG8_SB(b, h) + boff + n * 2048 + k * 1024); } while (0)
#define PG8_MMA(ai, bj, At, Bt) do { __builtin_amdgcn_s_setprio(1); _Pragma("unroll") for (int m = 0; m < 4; ++m) _Pragma("unroll") for (int n = 0; n < 2; ++n) _Pragma("unroll") for (int k = 0; k < 2; ++k) \
        acc[ai][bj][m][n] = __builtin_amdgcn_mfma_f32_16x16x32_bf16(Bt[n][k], At[m][k], acc[ai][bj][m][n], 0, 0, 0); __builtin_amdgcn_s_setprio(0); } while (0)
#define PG8_WAIT_V(n) asm volatile("s_waitcnt vmcnt(" #n ")" ::: "memory")
#define PG8_WAIT_L(n) asm volatile("s_waitcnt lgkmcnt(" #n ")" ::: "memory")
#define PG8_BAR __builtin_amdgcn_s_barrier()
#define PG8_SCHED __builtin_amdgcn_sched_barrier(0)
    Unit cur, nxt; int ui = 0;
    if (!S.next(0, cur)) return;
    f32x4 acc[2][2][4][2];
#pragma unroll
    for (int a = 0; a < 2; ++a)
#pragma unroll
        for (int b = 0; b < 2; ++b)
#pragma unroll
            for (int m = 0; m < 4; ++m)
#pragma unroll
                for (int n = 0; n < 2; ++n) acc[a][b][m][n] = (f32x4){0.f, 0.f, 0.f, 0.f};
    bf16x8 At[4][2], B0[2][2], B1[2][2];
    const char* cA = (const char*)g.A + (size_t)cur.pm * tstep; const char* cB = (const char*)g.Bt + (size_t)cur.pn * tstep;
    S.a_ready(cur);
    if constexpr (SP2) {
        PG8_STAGE(PG8_SB(0, 0), cB, voffB); PG8_STAGE(PG8_SB(0, 1), cB + hstep, voffB); PG8_STAGE(PG8_SA(0, 0), cA, voffA); PG8_STAGE(PG8_SA(0, 1), cA + hstep, voffA);
        if (wr == 1) PG8_BAR;
        PG8_WAIT_V(2); PG8_BAR;
        PG8_STAGE(PG8_SB(1, 0), cB + kstep, voffB); PG8_STAGE(PG8_SA(1, 0), cA + kstep, voffA); PG8_STAGE(PG8_SB(1, 1), cB + hstep + kstep, voffB);
        PG8_WAIT_V(6); PG8_BAR;
    } else {
        PG8_STAGE(PG8_SB(0, 0), cB, voffB); PG8_STAGE(PG8_SA(0, 0), cA, voffA); PG8_STAGE(PG8_SB(0, 1), cB + hstep, voffB); PG8_STAGE(PG8_SA(0, 1), cA + hstep, voffA);
        if (wr == 1) PG8_BAR;
        PG8_WAIT_V(4); PG8_BAR;
        PG8_STAGE(PG8_SB(1, 0), cB + kstep, voffB); PG8_STAGE(PG8_SA(1, 0), cA + kstep, voffA); PG8_STAGE(PG8_SB(1, 1), cB + hstep + kstep, voffB);
        PG8_WAIT_V(6); PG8_BAR;
    }
    for (;;) {
        const bool has_next = S.next(ui + 1, nxt);
        const char* nA = has_next ? (const char*)g.A + (size_t)nxt.pm * tstep : cA; const char* nB = has_next ? (const char*)g.Bt + (size_t)nxt.pn * tstep : cB;
        for (int t = 0; t < nt; t += 2) {
            const bool last = (t == nt - 2);
            const char* a1 = cA + (size_t)(t + 1) * kstep;
            const char* a2 = last ? nA : cA + (size_t)(t + 2) * kstep; const char* b2 = last ? nB : cB + (size_t)(t + 2) * kstep;
            const char* a3 = a2 + kstep; const char* b3 = b2 + kstep;
            if (last && has_next) S.a_ready(nxt);
            if constexpr (SP2) {
            PG8_LDB(B0, 0, 0); PG8_LDB(B1, 0, 1); PG8_SCHED; PG8_LDA(At, 0, 0); PG8_STAGE(PG8_SA(1, 1), a1 + hstep, voffA);
            PG8_WAIT_V(8); PG8_WAIT_L(0); PG8_BAR; PG8_MMA(0, 0, At, B0); PG8_MMA(0, 1, At, B1); PG8_BAR; PG8_SCHED;
            PG8_LDA(At, 0, 1); PG8_STAGE(PG8_SB(0, 0), b2, voffB); PG8_STAGE(PG8_SB(0, 1), b2 + hstep, voffB); PG8_STAGE(PG8_SA(0, 0), a2, voffA);
            PG8_WAIT_V(8); PG8_WAIT_L(0); PG8_BAR; PG8_MMA(1, 0, At, B0); PG8_MMA(1, 1, At, B1); PG8_BAR; PG8_SCHED;
            PG8_LDB(B0, 1, 0); PG8_LDB(B1, 1, 1); PG8_SCHED; PG8_LDA(At, 1, 0); PG8_STAGE(PG8_SA(0, 1), a2 + hstep, voffA);
            PG8_WAIT_V(8); PG8_WAIT_L(0); PG8_BAR; PG8_MMA(0, 0, At, B0); PG8_MMA(0, 1, At, B1); PG8_BAR; PG8_SCHED;
            PG8_LDA(At, 1, 1); PG8_STAGE(PG8_SB(1, 0), b3, voffB); PG8_STAGE(PG8_SB(1, 1), b3 + hstep, voffB); PG8_STAGE(PG8_SA(1, 0), a3, voffA);
            PG8_WAIT_V(8); PG8_WAIT_L(0); PG8_BAR; PG8_MMA(1, 0, At, B0); PG8_MMA(1, 1, At, B1); PG8_BAR; PG8_SCHED;
            } else {
            PG8_LDB(B0, 0, 0); PG8_SCHED; PG8_LDA(At, 0, 0); PG8_STAGE(PG8_SA(1, 1), a1 + hstep, voffA);
            PG8_WAIT_L(8); PG8_BAR; PG8_WAIT_L(0); PG8_MMA(0, 0, At, B0); PG8_BAR; PG8_SCHED;
            PG8_LDB(B1, 0, 1); PG8_STAGE(PG8_SB(0, 0), b2, voffB);
            PG8_BAR; PG8_WAIT_L(0); PG8_MMA(0, 1, At, B1); PG8_BAR;
            PG8_LDA(At, 0, 1); PG8_STAGE(PG8_SA(0, 0), a2, voffA);
            PG8_BAR; PG8_WAIT_L(0); PG8_MMA(1, 0, At, B0); PG8_BAR; PG8_SCHED;
            PG8_STAGE(PG8_SB(0, 1), b2 + hstep, voffB);
            PG8_WAIT_V(6); PG8_BAR; PG8_MMA(1, 1, At, B1); PG8_BAR;
            PG8_LDB(B0, 1, 0); PG8_SCHED; PG8_LDA(At, 1, 0); PG8_STAGE(PG8_SA(0, 1), a2 + hstep, voffA);
            PG8_WAIT_L(8); PG8_BAR; PG8_WAIT_L(0); PG8_MMA(0, 0, At, B0); PG8_BAR; PG8_SCHED;
            PG8_LDB(B1, 1, 1); PG8_STAGE(PG8_SB(1, 0), b3, voffB);
            PG8_BAR; PG8_WAIT_L(0); PG8_MMA(0, 1, At, B1); PG8_BAR;
            PG8_LDA(At, 1, 1); PG8_STAGE(PG8_SA(1, 0), a3, voffA);
            PG8_BAR; PG8_WAIT_L(0); PG8_MMA(1, 0, At, B0); PG8_BAR; PG8_SCHED;
            PG8_STAGE(PG8_SB(1, 1), b3 + hstep, voffB);
            PG8_WAIT_V(6); PG8_BAR; PG8_MMA(1, 1, At, B1); PG8_BAR;
            }
        }
        if constexpr (ALIGN_EPI) { if (wr == 0) PG8_BAR; }
        if constexpr (!Epi::AFTER_DRAIN) { E(acc, cur, wr, wc, fr, fq); S.done(cur); }
        if (!has_next) break;
#pragma unroll
        for (int a = 0; a < 2; ++a)
#pragma unroll
            for (int b = 0; b < 2; ++b)
#pragma unroll
                for (int m = 0; m < 4; ++m)
#pragma unroll
                    for (int n = 0; n < 2; ++n) acc[a][b][m][n] = (f32x4){0.f, 0.f, 0.f, 0.f};
        cur = nxt; cA = nA; cB = nB; ++ui;
        if constexpr (ALIGN_EPI) { if (wr == 1) PG8_BAR; }
    }
    PG8_WAIT_V(0);
    if constexpr (!ALIGN_EPI) { if (wr == 0) PG8_BAR; }
    PG8_BAR;
    if constexpr (Epi::AFTER_DRAIN) { E.fused(acc, cur, wr, wc, fr, fq, lds, wid, lane); S.done(cur); }
#undef PG8_SA
#undef PG8_SB
#undef PG8_STAGE
#undef PG8_LDA
#undef PG8_LDB
#undef PG8_MMA
#undef PG8_WAIT_V
#undef PG8_WAIT_L
#undef PG8_BAR
#undef PG8_SCHED
}
}

#define GAS __attribute__((address_space(1)))
#define LAS __attribute__((address_space(3)))
typedef unsigned short bf16;
typedef unsigned v4u __attribute__((ext_vector_type(4)));
typedef float f32x4 __attribute__((ext_vector_type(4)));
typedef short bf16x8 __attribute__((ext_vector_type(8)));
typedef GAS unsigned gu32;
typedef GAS unsigned long long gu64;
#define RLX_AGENT __ATOMIC_RELAXED, __HIP_MEMORY_SCOPE_AGENT
#define LDS_WAIT() asm volatile("s_waitcnt lgkmcnt(0)" ::: "memory")
#define VM_WAIT() asm volatile("s_waitcnt vmcnt(0)" ::: "memory")
__device__ __forceinline__ unsigned long long rt() { return __builtin_amdgcn_s_memrealtime(); }
__device__ __forceinline__ unsigned f2bf(float f) { unsigned u = __builtin_bit_cast(unsigned, f); return (u + 0x7fffu + ((u >> 16) & 1u)) >> 16; }
__device__ __forceinline__ unsigned pk2(float lo, float hi) { return f2bf(lo) | (f2bf(hi) << 16); }

#define XB_TMO      128
#define XB_XCNT(j)  (256  + 64 * (j))
#define XB_XSUB(j)  (1280 + 64 * (j))
#define XB_XGEN(j)  (2304 + 64 * (j))
#define XB_TOP      3328
#define XB_TOPGEN   3392
#define XCD_BAR_WORDS 3456
#define XB_SPIN_CAP (1u << 18)

__device__ __forceinline__ unsigned xb_ld(unsigned* p)              { return __hip_atomic_load(p, __ATOMIC_RELAXED, __HIP_MEMORY_SCOPE_AGENT); }
__device__ __forceinline__ unsigned xb_add(unsigned* p, unsigned v) { return __hip_atomic_fetch_add(p, v, __ATOMIC_RELAXED, __HIP_MEMORY_SCOPE_AGENT); }
__device__ __forceinline__ unsigned xb_xcc_id() { return (unsigned)__builtin_amdgcn_s_getreg((3 << 11) | 20) & 0xFu; }
#define XB_SPIN(cond, bar) do { unsigned _sp = 0; while (cond) { __builtin_amdgcn_s_sleep(1); \
    if ((++_sp & 255u) == 0u) { if (xb_ld(&(bar)[XB_TMO])) break; if (_sp > XB_SPIN_CAP) { atomicAdd(&(bar)[XB_TMO], 1u); break; } } } } while (0)

struct XcdBarrier {
    unsigned* bar; unsigned x;
    volatile LAS unsigned* st;
};

__device__ __forceinline__ XcdBarrier xcd_barrier_post(unsigned* bar, volatile LAS unsigned* st) {
    XcdBarrier b; b.bar = bar; b.x = xb_xcc_id(); b.st = st;
    if (threadIdx.x == 0) (void)xb_add(&bar[XB_XCNT(b.x)], 1u);
    return b;
}
__device__ __forceinline__ void xcd_barrier_complete(unsigned* bar, unsigned x, unsigned& nloc, unsigned& nx) {
    const unsigned G = gridDim.x * gridDim.y * gridDim.z;
    unsigned sum, cnt, mine, sp = 0u;
    for (;;) {
        sum = 0u; cnt = 0u; mine = 0u;
#pragma unroll
        for (unsigned j = 0; j < 16; ++j) { const unsigned c = xb_ld(&bar[XB_XCNT(j)]); sum += c; cnt += (c > 0u) ? 1u : 0u; mine = (j == x) ? c : mine; }
        if (sum == G) break;
        __builtin_amdgcn_s_sleep(1);
        if ((++sp & 255u) == 0u) { if (xb_ld(&bar[XB_TMO])) break; if (sp > XB_SPIN_CAP) { atomicAdd(&bar[XB_TMO], 1u); break; } }
    }
    nloc = mine > 0u ? mine : 1u; nx = cnt > 0u ? cnt : 1u;
}

__device__ __forceinline__ void xcd_barrier(const XcdBarrier& b) {
    asm volatile("s_waitcnt vmcnt(0)" ::: "memory");
    __syncthreads();
    if (threadIdx.x == 0) {
        unsigned* bar = b.bar;
        __builtin_amdgcn_s_waitcnt(0);
        unsigned nloc = b.st[0], nx = b.st[1];
        if (nloc == 0u) { xcd_barrier_complete(bar, b.x, nloc, nx); b.st[0] = nloc; b.st[1] = nx; }
        const unsigned old = xb_add(&bar[XB_XSUB(b.x)], 1u);
        const unsigned gen = old / nloc;
        if (old + 1u == (gen + 1u) * nloc) {
            __builtin_amdgcn_fence(__ATOMIC_RELEASE, "agent");
            asm volatile("s_waitcnt vmcnt(0)" ::: "memory");
            const unsigned og = xb_add(&bar[XB_TOP], 1u);
            const unsigned tg = og / nx;
            if (og + 1u == (tg + 1u) * nx) xb_add(&bar[XB_TOPGEN], 1u);
            else XB_SPIN(xb_ld(&bar[XB_TOPGEN]) == tg, bar);
            __builtin_amdgcn_fence(__ATOMIC_ACQUIRE, "agent");
            xb_add(&bar[XB_XGEN(b.x)], 1u);
            asm volatile("s_waitcnt vmcnt(0)" ::: "memory");
        } else {
            XB_SPIN(xb_ld(&bar[XB_XGEN(b.x)]) == gen, bar);
            __builtin_amdgcn_fence(__ATOMIC_ACQUIRE, "agent");
            asm volatile("s_waitcnt vmcnt(0)" ::: "memory");
        }
    }
    __syncthreads();
}

typedef float f32x2 __attribute__((ext_vector_type(2)));
namespace att {
using bf16x8 = __attribute__((ext_vector_type(8))) short;
using s16x4  = __attribute__((ext_vector_type(4))) short;
using f32x16 = __attribute__((ext_vector_type(16))) float;
using u32x4  = __attribute__((ext_vector_type(4))) unsigned;
typedef __attribute__((address_space(3))) char* lptr;
typedef __attribute__((address_space(3))) const char* lcptr;
constexpr int NW = 8, QBLK = 32, KVBLK = 64, LDQ = 1024, LDK = 256;
constexpr float THRL = 8.f;
constexpr int SHM_V = 16384, SHM_K = 16384, OFF_K = 2 * SHM_V, OFF_WS = 2 * SHM_V + 2 * SHM_K, OFF_STG = OFF_WS + NW * 64 * 4, STG_ROW = 272, STG_WAVE = 32 * STG_ROW;
constexpr int ATT_LDS = OFF_STG + NW * STG_WAVE;
#define KSWZ(row, colB) ((row) * 256 + ((colB) ^ (((row) & 7) << 4)))
#define SBAR() __builtin_amdgcn_sched_barrier(0)
__device__ __forceinline__ int crow(int r, int hi) { return (r & 3) + 8 * (r >> 2) + 4 * hi; }
__device__ __forceinline__ unsigned cvtpk(float lo, float hi) { unsigned r; asm volatile("v_cvt_pk_bf16_f32 %0, %1, %2" : "=v"(r) : "v"(lo), "v"(hi)); return r; }

__device__ __forceinline__ void partialSM(f32x16& p0, f32x16& p1, float& m_reg, float& mn, float& alpha) {
  float pmax = p0[0];
#pragma unroll
  for (int r = 1; r < 16; ++r) pmax = fmaxf(pmax, p0[r]);
#pragma unroll
  for (int r = 0; r < 16; ++r) pmax = fmaxf(pmax, p1[r]);
  { auto rr = __builtin_amdgcn_permlane32_swap(__float_as_uint(pmax), __float_as_uint(pmax), false, false);
    pmax = fmaxf(__uint_as_float(rr[0]), __uint_as_float(rr[1])); }
  if (__builtin_expect(__all(pmax - m_reg <= THRL), 1)) { mn = m_reg; alpha = 1.f; }
  else { mn = fmaxf(m_reg, pmax); alpha = __builtin_amdgcn_exp2f(m_reg - mn); m_reg = mn; }
#pragma unroll
  for (int r = 0; r < 16; ++r) { p0[r] -= mn; p1[r] -= mn; }
#pragma unroll
  for (int r = 0; r < 16; ++r) p0[r] = __builtin_amdgcn_exp2f(p0[r]);
}
__device__ __forceinline__ void finishSM(f32x16& p0, f32x16& p1, float alpha, float& l_reg, bf16x8& pa0, bf16x8& pa1, bf16x8& pa2, bf16x8& pa3) {
#pragma unroll
  for (int r = 0; r < 16; ++r) p1[r] = __builtin_amdgcn_exp2f(p1[r]);
  float ps = 0;
#pragma unroll
  for (int r = 0; r < 16; ++r) ps += p0[r];
#pragma unroll
  for (int r = 0; r < 16; ++r) ps += p1[r];
  { auto rr = __builtin_amdgcn_permlane32_swap(__float_as_uint(ps), __float_as_uint(ps), false, false);
    ps = __uint_as_float(rr[0]) + __uint_as_float(rr[1]); }
  l_reg = l_reg * alpha + ps;
#define PK4(P, BASE, OUT) do { unsigned a0 = cvtpk(P[BASE + 0], P[BASE + 1]), a1 = cvtpk(P[BASE + 2], P[BASE + 3]);   \
    unsigned b0 = cvtpk(P[BASE + 4], P[BASE + 5]), b1 = cvtpk(P[BASE + 6], P[BASE + 7]);                              \
    auto r0 = __builtin_amdgcn_permlane32_swap(a0, b0, false, false); auto r1 = __builtin_amdgcn_permlane32_swap(a1, b1, false, false); \
    u32x4 w = {r0[0], r1[0], r0[1], r1[1]}; OUT = __builtin_bit_cast(bf16x8, w); } while (0)
  PK4(p0, 0, pa0); PK4(p0, 8, pa1); PK4(p1, 0, pa2); PK4(p1, 8, pa3);
#undef PK4
}
__device__ __forceinline__ void qkt(f32x16& p0, f32x16& p1, lcptr Ks, const bf16x8* qr, int r32, int hi) {
  p0 = f32x16{}; p1 = f32x16{};
#pragma unroll
  for (int d0 = 0; d0 < 8; ++d0) { const int cb = (d0 * 16 + hi * 8) * 2;
    const bf16x8 b0 = *(const __attribute__((address_space(3))) bf16x8*)(Ks + KSWZ(r32, cb));
    const bf16x8 b1 = *(const __attribute__((address_space(3))) bf16x8*)(Ks + KSWZ(32 + r32, cb));
    p0 = __builtin_amdgcn_mfma_f32_32x32x16_bf16(b0, qr[d0], p0, 0, 0, 0);
    p1 = __builtin_amdgcn_mfma_f32_32x32x16_bf16(b1, qr[d0], p1, 0, 0, 0); }
}
__device__ __forceinline__ int v_st(int k, int c) { const int kk = (k & ~0xC) | ((k & 4) << 1) | ((k & 8) >> 1); return ((kk >> 3) * 4 + (c >> 5)) * 512 + ((kk & 7) * 32 + (c & 31)) * 2; }
__device__ __forceinline__ int v_rd_base(int lane) { return ((lane & 3) << 3) | (((lane >> 2) & 3) << 6) | (((lane >> 4) & 1) << 5) | (((lane >> 5) & 1) << 8); }
constexpr int v_rd_off(int d0, int ks, int half) { return d0 * 512 + ks * 4096 + half * 2048; }
template <int OFF> __device__ __forceinline__ s16x4 tr_read(int vb) {
  s16x4 r; asm volatile("ds_read_b64_tr_b16 %0, %1 offset:%2" : "=&v"(r) : "v"(vb), "i"(OFF) : "memory"); return r;
}
template <int D0> __device__ __forceinline__ void pv_one(f32x16& od, int vb, bf16x8 pa0, bf16x8 pa1, bf16x8 pa2, bf16x8 pa3) {
  const s16x4 l0 = tr_read<v_rd_off(D0, 0, 0)>(vb), h0 = tr_read<v_rd_off(D0, 0, 1)>(vb), l1 = tr_read<v_rd_off(D0, 1, 0)>(vb), h1 = tr_read<v_rd_off(D0, 1, 1)>(vb);
  const s16x4 l2 = tr_read<v_rd_off(D0, 2, 0)>(vb), h2 = tr_read<v_rd_off(D0, 2, 1)>(vb), l3 = tr_read<v_rd_off(D0, 3, 0)>(vb), h3 = tr_read<v_rd_off(D0, 3, 1)>(vb);
  asm volatile("s_waitcnt lgkmcnt(0)" ::: "memory"); SBAR();
#define PK(L, H) (bf16x8){L[0], L[1], L[2], L[3], H[0], H[1], H[2], H[3]}
  od = __builtin_amdgcn_mfma_f32_32x32x16_bf16(pa0, PK(l0, h0), od, 0, 0, 0);
  od = __builtin_amdgcn_mfma_f32_32x32x16_bf16(pa1, PK(l1, h1), od, 0, 0, 0);
  od = __builtin_amdgcn_mfma_f32_32x32x16_bf16(pa2, PK(l2, h2), od, 0, 0, 0);
  od = __builtin_amdgcn_mfma_f32_32x32x16_bf16(pa3, PK(l3, h3), od, 0, 0, 0);
#undef PK
}
__device__ __forceinline__ void pv_d0(f32x16* o, int vb, bf16x8 pa0, bf16x8 pa1, bf16x8 pa2, bf16x8 pa3) {
  pv_one<0>(o[0], vb, pa0, pa1, pa2, pa3); pv_one<1>(o[1], vb, pa0, pa1, pa2, pa3); pv_one<2>(o[2], vb, pa0, pa1, pa2, pa3); pv_one<3>(o[3], vb, pa0, pa1, pa2, pa3);
}
__device__ __forceinline__ void wmask(f32x16& p0, f32x16& p1, int qpos, int kpos0, int hi) {
#pragma unroll
  for (int r = 0; r < 16; ++r) { const int d = qpos - (kpos0 + crow(r, hi)); if (d > 128 || d < -128) p0[r] = -1e30f; const int d1 = d - 32; if (d1 > 128 || d1 < -128) p1[r] = -1e30f; }
}

template <int MODE, int SDEPTH>
__device__ __forceinline__ void attn_unit(const bf16* __restrict__ Qb, const bf16* __restrict__ Kh, const bf16* __restrict__ Vh, int NT, int q0, int ws_, float m_init, float l_init,
                                          const bf16* __restrict__ gate, int ldg, bf16* __restrict__ Ob, lptr lds) {
  const int tid = threadIdx.x, wid = __builtin_amdgcn_readfirstlane(tid >> 6), lane = tid & 63, r32 = lane & 31, hi = lane >> 5;
  const lptr V_lds = lds, K_lds = lds + OFF_K;
  __attribute__((address_space(3))) float* wsf = (__attribute__((address_space(3))) float*)(lds + OFF_WS) + wid * 64;
  __attribute__((address_space(3))) float* li_l = wsf; __attribute__((address_space(3))) float* al_l = wsf + 32;
  float m_reg = m_init, l_reg = l_init; f32x16 o[4] = {}; bf16x8 qr[8];
  const bf16* Qw = Qb + (long)(wid * QBLK + r32) * LDQ + hi * 8;
#pragma unroll
  for (int d0 = 0; d0 < 8; ++d0) qr[d0] = *(const bf16x8*)(Qw + d0 * 16);
  const int sr = tid >> 4, sc = (tid & 15) * 8, vst0 = v_st(sr, sc), vst1 = v_st(32 + sr, sc);
  const int vb0 = (int)(uintptr_t)V_lds + v_rd_base(lane);
  const int kwin0 = 512 + ws_;
  const int qpos = q0 + wid * QBLK + r32;
  struct { bf16x8 vs0, vs1, ks0, ks1; } sr_[SDEPTH];
#define KOFS(t) (MODE ? ((t) < 8 ? (t) * KVBLK : kwin0 + ((t) - 8) * KVBLK) : (t) * KVBLK)
#define SLOAD(i, t) do { const int k0_ = KOFS(t); sr_[i].vs0 = *(const bf16x8*)(&Vh[(long)(k0_ + sr) * LDK + sc]); sr_[i].vs1 = *(const bf16x8*)(&Vh[(long)(k0_ + 32 + sr) * LDK + sc]); \
    sr_[i].ks0 = *(const bf16x8*)(&Kh[(long)(k0_ + sr) * LDK + sc]); sr_[i].ks1 = *(const bf16x8*)(&Kh[(long)(k0_ + 32 + sr) * LDK + sc]); } while (0)
#define SWRITE(b, i) do { *(__attribute__((address_space(3))) bf16x8*)(V_lds + (b) * SHM_V + vst0) = sr_[i].vs0;          \
    *(__attribute__((address_space(3))) bf16x8*)(V_lds + (b) * SHM_V + vst1) = sr_[i].vs1; const int kc = sc * 2;               \
    *(__attribute__((address_space(3))) bf16x8*)(K_lds + (b) * SHM_K + KSWZ(sr, kc)) = sr_[i].ks0;                       \
    *(__attribute__((address_space(3))) bf16x8*)(K_lds + (b) * SHM_K + KSWZ(32 + sr, kc)) = sr_[i].ks1; } while (0)
#define SWAIT() do { if constexpr (SDEPTH == 2) asm volatile("s_waitcnt vmcnt(4)" ::: "memory"); else asm volatile("s_waitcnt vmcnt(0)" ::: "memory"); } while (0)
#define RESC(a) do { if (__any((a) < 1.f)) { if (hi == 0) al_l[r32] = (a); asm volatile("s_waitcnt lgkmcnt(0)" ::: "memory"); \
    _Pragma("unroll") for (int d = 0; d < 4; ++d) _Pragma("unroll") for (int r = 0; r < 16; ++r) o[d][r] *= al_l[crow(r, hi)]; } } while (0)
#define WMASK(P0, P1, t) do { if (MODE && (t) >= 8) { const int kp_ = ws_ + ((t) - 8) * KVBLK; const int qw_ = q0 + wid * QBLK; \
    if (!(kp_ >= qw_ + 31 - 128 && kp_ + 63 <= qw_ + 128)) wmask(P0, P1, qpos, kp_, hi); } } while (0)
  f32x16 pA0, pA1, pB0, pB1; float mnA, mnB, alA, alB; bf16x8 pa0, pa1, pa2, pa3;
  constexpr int SE = 0, SO = SDEPTH - 1;
  SLOAD(SE, 0); asm volatile("s_waitcnt vmcnt(0)" ::: "memory"); SWRITE(0, SE); __syncthreads();
  qkt(pA0, pA1, K_lds, qr, r32, hi); partialSM(pA0, pA1, m_reg, mnA, alA);
  SLOAD(SO, 1); if constexpr (SDEPTH == 2) { if (2 < NT) SLOAD(SE, 2); }
  SWAIT(); SWRITE(1, SO); __syncthreads();
  for (int j = 1; j + 1 < NT; j += 2) {
    SBAR(); qkt(pB0, pB1, K_lds + SHM_K, qr, r32, hi); WMASK(pB0, pB1, j);
    finishSM(pA0, pA1, alA, l_reg, pa0, pa1, pa2, pa3); SBAR();
    SLOAD(SO, j + SDEPTH); SBAR();
    pv_d0(o, vb0, pa0, pa1, pa2, pa3); partialSM(pB0, pB1, m_reg, mnB, alB);
    __syncthreads(); SWAIT(); SWRITE(0, SE);
    RESC(alB); __syncthreads();
    SBAR(); qkt(pA0, pA1, K_lds, qr, r32, hi); WMASK(pA0, pA1, j + 1);
    finishSM(pB0, pB1, alB, l_reg, pa0, pa1, pa2, pa3); SBAR();
    if (SDEPTH == 1 || j + 3 < NT) SLOAD(SE, j + 1 + SDEPTH); SBAR();
    pv_d0(o, vb0 + SHM_V, pa0, pa1, pa2, pa3); partialSM(pA0, pA1, m_reg, mnA, alA);
    __syncthreads(); SWAIT(); SWRITE(1, SO);
    RESC(alA); __syncthreads();
  }
  SBAR(); qkt(pB0, pB1, K_lds + SHM_K, qr, r32, hi); WMASK(pB0, pB1, NT - 1);
  finishSM(pA0, pA1, alA, l_reg, pa0, pa1, pa2, pa3); SBAR();
  pv_d0(o, vb0, pa0, pa1, pa2, pa3); partialSM(pB0, pB1, m_reg, mnB, alB);
  __syncthreads(); RESC(alB);
  finishSM(pB0, pB1, alB, l_reg, pa0, pa1, pa2, pa3); SBAR();
  pv_d0(o, vb0 + SHM_V, pa0, pa1, pa2, pa3);
  if (hi == 0) li_l[r32] = l_reg; asm volatile("s_waitcnt lgkmcnt(0)" ::: "memory");
  float rli[16];
#pragma unroll
  for (int r = 0; r < 16; ++r) rli[r] = __builtin_amdgcn_rcpf(li_l[crow(r, hi)]);
  const lptr stg = lds + OFF_STG + wid * STG_WAVE;
#pragma unroll
  for (int r = 0; r < 16; ++r) { const int orow = crow(r, hi);
#pragma unroll
    for (int d0 = 0; d0 < 4; ++d0) { const unsigned short hv = (unsigned short)(cvtpk(o[d0][r] * rli[r], 0.f) & 0xffffu);
      *(__attribute__((address_space(3))) unsigned short*)(stg + orow * STG_ROW + (d0 * 32 + r32) * 2) = hv; } }
  asm volatile("s_waitcnt lgkmcnt(0)" ::: "memory");
#pragma unroll
  for (int i = 0; i < 8; ++i) { const int id = i * 64 + lane, row = id >> 4, ch = id & 15;
    const u32x4 ov = *(const __attribute__((address_space(3))) u32x4*)(stg + row * STG_ROW + ch * 16);
    const u32x4 gv = *(const u32x4*)(gate + (long)(wid * QBLK + row) * ldg + ch * 8);
    u32x4 w;
#pragma unroll
    for (int e = 0; e < 4; ++e) { const float g0 = __uint_as_float(gv[e] << 16), g1 = __uint_as_float(gv[e] & 0xffff0000u);
      const float x0 = __uint_as_float(ov[e] << 16), x1 = __uint_as_float(ov[e] & 0xffff0000u);
      w[e] = cvtpk(x0 * (g0 / (1.0f + __expf(-g0))), x1 * (g1 / (1.0f + __expf(-g1)))); }
    *(u32x4*)(Ob + (long)(wid * QBLK + row) * 2048 + ch * 8) = w; }
  asm volatile("s_waitcnt lgkmcnt(0)" ::: "memory");
#undef KOFS
#undef SLOAD
#undef SWRITE
#undef SWAIT
#undef RESC
#undef WMASK
}
#undef KSWZ
#undef SBAR
}

constexpr int NWAVES = 8;
#ifndef MK_N_LAUNCHES
#define MK_N_LAUNCHES 1
#endif
constexpr int NPH = 12;
constexpr int DM = 2048, NCTX = 4096, NLAT = 16384, MROWS = 20480, IN0 = 5632, IN1 = 6656;
constexpr float EPS = 1e-6f, LOG2E = 1.4426950408889634f;
constexpr float QSCALE = 0.08838834764831845f * LOG2E;

constexpr size_t MiB = 1u << 20;
constexpr size_t WS_CTL = 0, CTL_ZERO_BYTES = 1 * MiB;
constexpr size_t WS_WIN0 = 2 * MiB, WS_WOUT0 = 24 * MiB, WS_WIN1 = 32 * MiB, WS_WOUT1 = 58 * MiB;
constexpr size_t WS_MOD = 66 * MiB;
constexpr size_t WS_ROPE = 67 * MiB;
constexpr size_t WS_KL0 = 72 * MiB, WS_VL0 = 82 * MiB, WS_KL1 = 92 * MiB, WS_VL1 = 102 * MiB;
constexpr size_t WS_KC = 112 * MiB, WS_VC = 114 * MiB;
constexpr size_t WS_H = 116 * MiB;
constexpr size_t WS_QP = 196 * MiB;
constexpr size_t WS_PROJ = 236 * MiB;
constexpr size_t WS_END = 496 * MiB;
constexpr int CW_BAR = 4096;
constexpr size_t OUT_K0 = (size_t)MROWS * DM, OUT_V0 = OUT_K0 + 1048576, OUT_K1 = OUT_K0 + 2 * 1048576, OUT_V1 = OUT_K0 + 3 * 1048576;

constexpr int RING_BYTES = 131072, LDS_BYTES = 147456, LDSCTL_OFF = LDS_BYTES - 1024, MISC_OFF = LDSCTL_OFF + 320;
static_assert(att::ATT_LDS <= LDSCTL_OFF, "attention scratch vs LDS control words");

struct Args { const float* in[27]; float* out; unsigned char* ws; int ph_lo, ph_hi; };

struct Frame {
    LAS unsigned char* lds;
    volatile LAS unsigned* MISC;
    int tid, lane, wave, vcu, G;
};

__device__ __forceinline__ float bf_lo(unsigned u) { return __uint_as_float(u << 16); }
__device__ __forceinline__ float bf_hi(unsigned u) { return __uint_as_float(u & 0xffff0000u); }
__device__ __forceinline__ float sigmoidf_(float x) { return 1.0f / (1.0f + __expf(-x)); }
__device__ __forceinline__ float siluf_(float x) { return x / (1.0f + __expf(-x)); }
__device__ __forceinline__ float wave_sum(float v) {
#pragma unroll
    for (int o = 1; o < 64; o <<= 1) v += __shfl_xor(v, o);
    return v;
}

__device__ __forceinline__ void p0_transpose_item(const float* W, int K, int N, bf16* WT, LAS float* scr, int item, int lane) {
    const int nblk = N / 32, kb = item / nblk, nb = item % nblk, k0 = 64 * kb, n0 = 32 * nb;
#pragma unroll 8
    for (int i = 0; i < 32; ++i) { const int kk = 2 * i + (lane >> 5); scr[kk * 33 + (lane & 31)] = W[(size_t)(k0 + kk) * N + n0 + (lane & 31)]; }
    LDS_WAIT(); asm volatile("" ::: "memory");
    const int c = lane & 7;
#pragma unroll
    for (int j = 0; j < 4; ++j) { const int n = (lane >> 3) + 8 * j; const LAS float* s = scr + (8 * c) * 33 + n;
        v4u o; o.x = pk2(s[0 * 33], s[1 * 33]); o.y = pk2(s[2 * 33], s[3 * 33]); o.z = pk2(s[4 * 33], s[5 * 33]); o.w = pk2(s[6 * 33], s[7 * 33]);
        *(GAS v4u*)(WT + (size_t)(n0 + n) * K + k0 + 8 * c) = o; }
    LDS_WAIT(); asm volatile("" ::: "memory");
}

__device__ __forceinline__ void p0_prologue(Frame& F, const Args& a) {
    unsigned char* ws = a.ws;
    float* MOD = (float*)(ws + WS_MOD);
    {
        LAS float* red = (LAS float*)F.lds;
        for (int it = blockIdx.x; it < 192; it += F.G) {
            const int l = it / 96, cg = it % 96, n = cg * 64 + F.lane, kb = F.wave * 256;
            const float* W = a.in[l ? 19 : 8]; const float* bias = a.in[l ? 20 : 9];
            float cs[9][4];
#pragma unroll
            for (int r = 0; r < 9; ++r)
#pragma unroll
                for (int j = 0; j < 4; ++j) { const int k = kb + 64 * j + F.lane; const float x = (r < 8) ? a.in[6][r * DM + k] : a.in[7][k]; cs[r][j] = x / (1.0f + expf(-x)); }
            float acc[9];
#pragma unroll
            for (int r = 0; r < 9; ++r) acc[r] = 0.f;
#pragma unroll
            for (int j = 0; j < 4; ++j) {
#pragma unroll 8
                for (int kk = 0; kk < 64; ++kk) {
                    const float w = W[(size_t)(kb + 64 * j + kk) * 6144 + n];
#pragma unroll
                    for (int r = 0; r < 9; ++r) acc[r] += __int_as_float(__builtin_amdgcn_readlane(__float_as_int(cs[r][j]), kk)) * w;
                }
            }
#pragma unroll
            for (int r = 0; r < 9; ++r) red[(F.wave * 9 + r) * 64 + F.lane] = acc[r];
            __syncthreads();
            for (int idx = F.tid; idx < 576; idx += 512) { const int r = idx >> 6, ln = idx & 63; float s = 0.f;
#pragma unroll
                for (int w = 0; w < 8; ++w) s += red[(w * 9 + r) * 64 + ln];
                MOD[(size_t)(l * 9 + r) * 6144 + cg * 64 + ln] = s + bias[cg * 64 + ln]; }
            __syncthreads();
        }
    }
    LAS float* scr = (LAS float*)(F.lds + F.wave * 16384);
    const int gw = F.vcu * NWAVES + F.wave, NGW = F.G * NWAVES;
    constexpr int I_IN0 = 32 * (IN0 / 32), I_OUT = 32 * (DM / 32), I_IN1 = 32 * (IN1 / 32), I_T = I_IN0 + I_OUT + I_IN1 + I_OUT, I_C = 4 * 2048, I_R = 32;
    for (int it = gw; it < I_T + I_C + I_R; it += NGW) {
        int r = it;
        if (r < I_IN0) { p0_transpose_item(a.in[11], DM, IN0, (bf16*)(ws + WS_WIN0), scr, r, F.lane); continue; } r -= I_IN0;
        if (r < I_OUT) { p0_transpose_item(a.in[18], DM, DM, (bf16*)(ws + WS_WOUT0), scr, r, F.lane); continue; } r -= I_OUT;
        if (r < I_IN1) { p0_transpose_item(a.in[22], DM, IN1, (bf16*)(ws + WS_WIN1), scr, r, F.lane); continue; } r -= I_IN1;
        if (r < I_OUT) { p0_transpose_item(a.in[25], DM, DM, (bf16*)(ws + WS_WOUT1), scr, r, F.lane); continue; } r -= I_OUT;
        if (r < I_C) {
            const int ts = r >> 11, wi = r & 2047, e0 = wi * 512 + F.lane * 8;
            const float* src = a.in[2 + ts] + e0;
            const f32x4 v0 = *(const f32x4*)src, v1 = *(const f32x4*)(src + 4);
            bf16* dst = (bf16*)(ws + (ts == 0 ? WS_KL0 : ts == 1 ? WS_VL0 : ts == 2 ? WS_KL1 : WS_VL1)) + (size_t)(e0 >> 17) * (2560 * 256) + (e0 & 131071);
            v4u o; o.x = pk2(v0[0], v0[1]); o.y = pk2(v0[2], v0[3]); o.z = pk2(v1[0], v1[1]); o.w = pk2(v1[2], v1[3]);
            *(v4u*)dst = o; continue; }
        r -= I_C;
        {
            const int idx = r * 64 + F.lane, pos = idx >> 5, j = idx & 31;
            const float inv = exp2f(-(float)j * (13.287712379549449f / 32.0f));
            double rev = (double)pos * (double)inv * 0.15915494309189535; rev -= floor(rev);
            float* T = (float*)(ws + WS_ROPE) + idx * 2;
            T[0] = __builtin_amdgcn_cosf((float)rev); T[1] = __builtin_amdgcn_sinf((float)rev);
        }
    }
}

__device__ __forceinline__ void h_rows(Frame& F, const Args& a, int layer, const float* xp, const float* xs, const float* g) {
    const float* MOD = (const float*)(a.ws + WS_MOD); bf16* H = (bf16*)(a.ws + WS_H);
    const int gw = F.vcu * NWAVES + F.wave, NGW = F.G * NWAVES;
    for (int row = gw; row < MROWS; row += NGW) {
        const float* src = row < NCTX ? xp + (size_t)row * DM : xs + (size_t)(row - NCTX) * DM;
        const int cr = row < NCTX ? 8 : ((row - NCTX) >> 11);
        const float* mod = MOD + (size_t)(layer * 9 + cr) * 6144;
        f32x4 v[8]; float ss = 0.f;
#pragma unroll
        for (int j = 0; j < 8; ++j) { v[j] = *(const f32x4*)(src + j * 256 + F.lane * 4); ss += (v[j][0] * v[j][0] + v[j][1] * v[j][1]) + (v[j][2] * v[j][2] + v[j][3] * v[j][3]); }
        const float rstd = 1.0f / sqrtf(wave_sum(ss) * (1.0f / DM) + EPS);
#pragma unroll
        for (int j = 0; j < 8; ++j) { const int c = j * 256 + F.lane * 4;
            const f32x4 gg = *(const f32x4*)(g + c), sh = *(const f32x4*)(mod + c), sc = *(const f32x4*)(mod + 2048 + c);
            const f32x4 y = (v[j] * rstd) * gg; const f32x4 h = y * (sc + 1.0f) + sh;
            unsigned long long o = (unsigned long long)pk2(h[0], h[1]) | ((unsigned long long)pk2(h[2], h[3]) << 32);
            *(unsigned long long*)(H + (size_t)row * DM + c) = o; }
    }
}

__device__ __forceinline__ void final_rows(Frame& F, const Args& a) {
    const float* g = a.in[26];
    const int gw = F.vcu * NWAVES + F.wave, NGW = F.G * NWAVES;
    for (int row = gw; row < MROWS; row += NGW) {
        float* p = a.out + (size_t)row * DM;
        f32x4 v[8]; float ss = 0.f;
#pragma unroll
        for (int j = 0; j < 8; ++j) { v[j] = *(const f32x4*)(p + j * 256 + F.lane * 4); ss += (v[j][0] * v[j][0] + v[j][1] * v[j][1]) + (v[j][2] * v[j][2] + v[j][3] * v[j][3]); }
        const float rstd = 1.0f / sqrtf(wave_sum(ss) * (1.0f / DM) + EPS);
#pragma unroll
        for (int j = 0; j < 8; ++j) { const int c = j * 256 + F.lane * 4; const f32x4 gg = *(const f32x4*)(g + c); *(f32x4*)(p + c) = (v[j] * rstd) * gg; }
    }
}

template <int R> struct ConvStep {
    static __device__ __forceinline__ void run(f32x2 (&out)[32], const f32x2 (&w)[31], const bf16* P, int rowbase, int S, int t0, int tid) {
        const int t = t0 - 15 + R; const bool valid = (t >= 0) && (t < S); const int tc = t < 0 ? 0 : (t >= S ? S - 1 : t);
        const bf16* pr = P + (size_t)(rowbase + tc) * IN0 + 2 * tid;
        const unsigned ga = *(const unsigned*)pr, gb = *(const unsigned*)(pr + 1024);
        f32x2 av; av.x = bf_lo(ga) * sigmoidf_(bf_lo(gb)); av.y = bf_hi(ga) * sigmoidf_(bf_hi(gb));
        if (!valid) { av.x = 0.f; av.y = 0.f; }
#pragma unroll
        for (int j = 0; j < 31; ++j) { const int tp = R - j; if (tp >= 0 && tp < 32) out[tp] += w[j] * av; }
        ConvStep<R + 1>::run(out, w, P, rowbase, S, t0, tid);
    }
};
template <> struct ConvStep<62> { static __device__ __forceinline__ void run(f32x2 (&)[32], const f32x2 (&)[31], const bf16*, int, int, int, int) {} };

__device__ __forceinline__ void conv0_items(Frame& F, const Args& a) {
    const bf16* P = (const bf16*)(a.ws + WS_PROJ); bf16* MIX = (bf16*)(a.ws + WS_H);
    const float* cw = a.in[12]; const float* cb = a.in[13]; const float* lng = a.in[14]; const float* lnb = a.in[15];
    LAS float* cv = (LAS float*)F.lds;
    const int tid = F.tid;
    f32x2 w[31];
#pragma unroll
    for (int j = 0; j < 31; ++j) w[j] = *(const f32x2*)(cw + j * 1024 + 2 * tid);
    const f32x2 bias = *(const f32x2*)(cb + 2 * tid);
    for (int ci = blockIdx.x; ci < 640; ci += F.G) {
        int rowbase, S, t0;
        if (ci < 128) { rowbase = (ci >> 3) * 256; S = 256; t0 = (ci & 7) * 32; } else { const int li = ci - 128; rowbase = NCTX + (li >> 6) * 2048; S = 2048; t0 = (li & 63) * 32; }
        f32x2 out[32];
#pragma unroll
        for (int i = 0; i < 32; ++i) out[i] = bias;
        ConvStep<0>::run(out, w, P, rowbase, S, t0, tid);
#pragma unroll
        for (int i = 0; i < 32; ++i) *(LAS f32x2*)(cv + i * 1024 + 2 * tid) = out[i];
        __syncthreads();
#pragma unroll 1
        for (int i = 0; i < 4; ++i) {
            const int tp = F.wave * 4 + i; const size_t row = (size_t)(rowbase + t0 + tp);
            f32x4 x[4]; float s = 0.f;
#pragma unroll
            for (int q = 0; q < 4; ++q) { x[q] = *(const LAS f32x4*)(cv + tp * 1024 + q * 256 + F.lane * 4); s += (x[q][0] + x[q][1]) + (x[q][2] + x[q][3]); }
            const float mean = wave_sum(s) * (1.0f / 1024.0f); float s2 = 0.f;
#pragma unroll
            for (int q = 0; q < 4; ++q) { x[q] = x[q] - mean; s2 += (x[q][0] * x[q][0] + x[q][1] * x[q][1]) + (x[q][2] * x[q][2] + x[q][3] * x[q][3]); }
            const float rstd = 1.0f / sqrtf(wave_sum(s2) * (1.0f / 1024.0f) + EPS);
#pragma unroll
            for (int q = 0; q < 4; ++q) { const int c = q * 256 + F.lane * 4;
                const f32x4 g4 = *(const f32x4*)(lng + c), b4 = *(const f32x4*)(lnb + c);
                const f32x4 y = (x[q] * rstd) * g4 + b4;
                const unsigned long long gt = *(const unsigned long long*)(P + row * IN0 + 2048 + c);
                const unsigned glo = (unsigned)gt, ghi = (unsigned)(gt >> 32);
                const float o0 = siluf_(y[0]) * siluf_(bf_lo(glo)), o1 = siluf_(y[1]) * siluf_(bf_hi(glo)), o2 = siluf_(y[2]) * siluf_(bf_lo(ghi)), o3 = siluf_(y[3]) * siluf_(bf_hi(ghi));
                *(unsigned long long*)(MIX + row * DM + c) = (unsigned long long)pk2(o0, o1) | ((unsigned long long)pk2(o2, o3) << 32); }
        }
        __syncthreads();
    }
}

template <int LAYER> __device__ __forceinline__ void prep_rows(Frame& F, const Args& a) {
    constexpr int ldc = LAYER ? IN1 : IN0, qoff = LAYER ? 0 : 3072, koff = LAYER ? 1024 : 4096, voff = LAYER ? 1280 : 4352;
    const bf16* P = (const bf16*)(a.ws + WS_PROJ); bf16* QP = (bf16*)(a.ws + WS_QP);
    bf16* KL = (bf16*)(a.ws + (LAYER ? WS_KL1 : WS_KL0)); bf16* VL = (bf16*)(a.ws + (LAYER ? WS_VL1 : WS_VL0));
    bf16* KC = (bf16*)(a.ws + WS_KC); bf16* VC = (bf16*)(a.ws + WS_VC);
    const float* ROPE = (const float*)(a.ws + WS_ROPE);
    const float* qg = a.in[16]; const float* kg = a.in[17];
    const int gw = F.vcu * NWAVES + F.wave, NGW = F.G * NWAVES, lane = F.lane;
    for (int row = gw; row < MROWS; row += NGW) {
        const bool lat = row >= NCTX; const int t = (row - NCTX) & 2047, b = (row - NCTX) >> 11, trow = t >> 6, tcol = t & 63;
        const bf16* pr = P + (size_t)row * ldc;
#pragma unroll
        for (int pass = 0; pass < 2; ++pass) {
            const int li = pass ? (lane & 15) : lane, c = li & 7;
            const bf16* src = pr + (pass ? koff : qoff) + li * 16;
            const v4u r0 = *(const v4u*)src, r1 = *(const v4u*)(src + 8);
            float x[16];
            x[0] = bf_lo(r0.x); x[1] = bf_hi(r0.x); x[2] = bf_lo(r0.y); x[3] = bf_hi(r0.y); x[4] = bf_lo(r0.z); x[5] = bf_hi(r0.z); x[6] = bf_lo(r0.w); x[7] = bf_hi(r0.w);
            x[8] = bf_lo(r1.x); x[9] = bf_hi(r1.x); x[10] = bf_lo(r1.y); x[11] = bf_hi(r1.y); x[12] = bf_lo(r1.z); x[13] = bf_hi(r1.z); x[14] = bf_lo(r1.w); x[15] = bf_hi(r1.w);
            if (LAYER == 0) {
                float ss = 0.f;
#pragma unroll
                for (int e = 0; e < 16; ++e) ss += x[e] * x[e];
                ss += __shfl_xor(ss, 1); ss += __shfl_xor(ss, 2); ss += __shfl_xor(ss, 4);
                const float rstd = 1.0f / sqrtf(ss * (1.0f / 128.0f) + EPS);
                const float* gp = (pass ? kg : qg) + c * 16;
#pragma unroll
                for (int e = 0; e < 16; ++e) x[e] = (x[e] * rstd) * gp[e];
            }
            if (lat) {
                const int cc = c & 3, pos = (c < 4) ? trow : tcol; const bool first = cc < 2;
                const float* tb = ROPE + (size_t)(pos * 32 + 16 * (cc & 1)) * 2;
#pragma unroll
                for (int e = 0; e < 16; ++e) { const float pv = __shfl_xor(x[e], 2); const float cs = tb[2 * e], sn = tb[2 * e + 1]; x[e] = first ? (x[e] * cs - pv * sn) : (x[e] * cs + pv * sn); }
            }
            if (pass == 0) {
                v4u o0, o1;
                o0.x = pk2(x[0] * QSCALE, x[1] * QSCALE); o0.y = pk2(x[2] * QSCALE, x[3] * QSCALE); o0.z = pk2(x[4] * QSCALE, x[5] * QSCALE); o0.w = pk2(x[6] * QSCALE, x[7] * QSCALE);
                o1.x = pk2(x[8] * QSCALE, x[9] * QSCALE); o1.y = pk2(x[10] * QSCALE, x[11] * QSCALE); o1.z = pk2(x[12] * QSCALE, x[13] * QSCALE); o1.w = pk2(x[14] * QSCALE, x[15] * QSCALE);
                bf16* dst = QP + (size_t)row * 1024 + lane * 16; *(v4u*)dst = o0; *(v4u*)(dst + 8) = o1;
            } else if (lane < 16) {
                v4u o0, o1;
                o0.x = pk2(x[0], x[1]); o0.y = pk2(x[2], x[3]); o0.z = pk2(x[4], x[5]); o0.w = pk2(x[6], x[7]);
                o1.x = pk2(x[8], x[9]); o1.y = pk2(x[10], x[11]); o1.z = pk2(x[12], x[13]); o1.w = pk2(x[14], x[15]);
                bf16* dst = lat ? KL + ((size_t)b * 2560 + 512 + t) * 256 + lane * 16 : KC + (size_t)row * 256 + lane * 16;
                *(v4u*)dst = o0; *(v4u*)(dst + 8) = o1;
                if (LAYER == 0 && !lat) { float* ko = a.out + OUT_K0 + (size_t)row * 256 + lane * 16;
#pragma unroll
                    for (int e = 0; e < 16; e += 4) *(f32x4*)(ko + e) = (f32x4){x[e], x[e + 1], x[e + 2], x[e + 3]}; }
            }
        }
        if (lane >= 32) {
            const int vl = lane - 32; const v4u vv = *(const v4u*)(pr + voff + vl * 8);
            bf16* dst = lat ? VL + ((size_t)b * 2560 + 512 + t) * 256 + vl * 8 : VC + (size_t)row * 256 + vl * 8;
            *(v4u*)dst = vv;
        }
    }
}

__device__ __forceinline__ void conv1_rows(Frame& F, const Args& a) {
    const bf16* P = (const bf16*)(a.ws + WS_PROJ); bf16* MIX = (bf16*)(a.ws + WS_H); const float* sw = a.in[24];
    const int gw = F.vcu * NWAVES + F.wave, NGW = F.G * NWAVES;
    for (int it = gw; it < MROWS * 2; it += NGW) {
        const int row = it >> 1, c0 = (it & 1) * 512 + F.lane * 8;
        int t, S; if (row < NCTX) { t = row & 255; S = 256; } else { t = (row - NCTX) & 2047; S = 2048; }
        const bf16* pr = P + (size_t)row * IN1;
        float cvv[8];
#pragma unroll
        for (int e = 0; e < 8; ++e) cvv[e] = 0.f;
#pragma unroll
        for (int j = 0; j < 3; ++j) {
            const int tt = t + j - 1;
            if (tt >= 0 && tt < S) {
                const bf16* pq = pr + (ptrdiff_t)(j - 1) * IN1;
                const v4u dc = *(const v4u*)(pq + 3584 + c0), dx = *(const v4u*)(pq + 4608 + c0);
                const f32x4 w0 = *(const f32x4*)(sw + j * 1024 + c0), w1 = *(const f32x4*)(sw + j * 1024 + c0 + 4);
                cvv[0] += w0[0] * (bf_lo(dc.x) * bf_lo(dx.x)); cvv[1] += w0[1] * (bf_hi(dc.x) * bf_hi(dx.x));
                cvv[2] += w0[2] * (bf_lo(dc.y) * bf_lo(dx.y)); cvv[3] += w0[3] * (bf_hi(dc.y) * bf_hi(dx.y));
                cvv[4] += w1[0] * (bf_lo(dc.z) * bf_lo(dx.z)); cvv[5] += w1[1] * (bf_hi(dc.z) * bf_hi(dx.z));
                cvv[6] += w1[2] * (bf_lo(dc.w) * bf_lo(dx.w)); cvv[7] += w1[3] * (bf_hi(dc.w) * bf_hi(dx.w));
            }
        }
        const v4u db = *(const v4u*)(pr + 2560 + c0), gd = *(const v4u*)(pr + 5632 + c0);
        v4u o;
        o.x = pk2(bf_lo(db.x) * cvv[0] * siluf_(bf_lo(gd.x)), bf_hi(db.x) * cvv[1] * siluf_(bf_hi(gd.x)));
        o.y = pk2(bf_lo(db.y) * cvv[2] * siluf_(bf_lo(gd.y)), bf_hi(db.y) * cvv[3] * siluf_(bf_hi(gd.y)));
        o.z = pk2(bf_lo(db.z) * cvv[4] * siluf_(bf_lo(gd.z)), bf_hi(db.z) * cvv[5] * siluf_(bf_hi(gd.z)));
        o.w = pk2(bf_lo(db.w) * cvv[6] * siluf_(bf_lo(gd.w)), bf_hi(db.w) * cvv[7] * siluf_(bf_hi(gd.w)));
        *(v4u*)(MIX + (size_t)row * DM + 1024 + c0) = o;
    }
}

template <int LAYER> __device__ __forceinline__ void attn_simple(Frame& F, const Args& a) {
    constexpr int ldc = LAYER ? IN1 : IN0, goff = LAYER ? 1536 : 4608, ocol = LAYER ? 0 : 1024;
    const bf16* P = (const bf16*)(a.ws + WS_PROJ); const bf16* QP = (const bf16*)(a.ws + WS_QP); bf16* MIX = (bf16*)(a.ws + WS_H);
    const bf16* KL = (const bf16*)(a.ws + (LAYER ? WS_KL1 : WS_KL0)); const bf16* VL = (const bf16*)(a.ws + (LAYER ? WS_VL1 : WS_VL0));
    const bf16* KC = (const bf16*)(a.ws + WS_KC); const bf16* VC = (const bf16*)(a.ws + WS_VC);
    const float* sink = a.in[23];
    const int gw = F.vcu * NWAVES + F.wave, NGW = F.G * NWAVES, lane = F.lane;
    for (int it = gw; it < MROWS * 8; it += NGW) {
        const int row = it >> 3, h = it & 7, kvh = h >> 2;
        const unsigned qq = *(const unsigned*)(QP + (size_t)row * 1024 + h * 128 + 2 * lane);
        const float q0 = bf_lo(qq), q1 = bf_hi(qq);
        const bf16* Kb; const bf16* Vb; int nA, b0, b1;
        if (row < NCTX) { const size_t o = (size_t)(row >> 8) * 65536 + kvh * 128 + 2 * lane; Kb = KC + o; Vb = VC + o; nA = 256; b0 = 0; b1 = 0; }
        else { const int t = (row - NCTX) & 2047, b = (row - NCTX) >> 11; const size_t o = (size_t)b * (2560 * 256) + kvh * 128 + 2 * lane; Kb = KL + o; Vb = VL + o;
            if (LAYER == 0) { nA = 2560; b0 = 0; b1 = 0; } else { nA = 512; b0 = 512 + (t > 128 ? t - 128 : 0); b1 = 512 + (t + 128 < 2047 ? t + 128 : 2047) + 1; } }
        float m, l, o0 = 0.f, o1 = 0.f;
        if (LAYER) { m = sink[h] * LOG2E; l = 1.f; } else { m = -1e30f; l = 0.f; }
#pragma unroll 1
        for (int rg = 0; rg < 2; ++rg) {
            const int js = rg ? b0 : 0, je = rg ? b1 : nA;
#pragma unroll 1
            for (int j = js; j < je; j += 4) {
                float s[4]; unsigned vv[4];
#pragma unroll
                for (int u = 0; u < 4; ++u) { const int jj = (j + u < je) ? j + u : je - 1; const unsigned kk = *(const unsigned*)(Kb + (size_t)jj * 256); vv[u] = *(const unsigned*)(Vb + (size_t)jj * 256); s[u] = q0 * bf_lo(kk) + q1 * bf_hi(kk); }
#pragma unroll
                for (int off = 1; off < 64; off <<= 1)
#pragma unroll
                    for (int u = 0; u < 4; ++u) s[u] += __shfl_xor(s[u], off);
#pragma unroll
                for (int u = 0; u < 4; ++u) if (j + u >= je) s[u] = -1e30f;
                const float mn = fmaxf(fmaxf(m, fmaxf(s[0], s[1])), fmaxf(s[2], s[3]));
                const float al = exp2f(m - mn);
                const float p0 = exp2f(s[0] - mn), p1 = exp2f(s[1] - mn), p2 = exp2f(s[2] - mn), p3 = exp2f(s[3] - mn);
                l = l * al + ((p0 + p1) + (p2 + p3));
                o0 = o0 * al + ((p0 * bf_lo(vv[0]) + p1 * bf_lo(vv[1])) + (p2 * bf_lo(vv[2]) + p3 * bf_lo(vv[3])));
                o1 = o1 * al + ((p0 * bf_hi(vv[0]) + p1 * bf_hi(vv[1])) + (p2 * bf_hi(vv[2]) + p3 * bf_hi(vv[3])));
                m = mn;
            }
        }
        const float inv = 1.0f / l;
        const unsigned gt = *(const unsigned*)(P + (size_t)row * ldc + goff + h * 128 + 2 * lane);
        *(unsigned*)(MIX + (size_t)row * DM + ocol + h * 128 + 2 * lane) = pk2(o0 * inv * siluf_(bf_lo(gt)), o1 * inv * siluf_(bf_hi(gt)));
    }
}

template <int LAYER> __device__ __forceinline__ void attn_phase(Frame& F, const Args& a) {
    constexpr int ldc = LAYER ? IN1 : IN0, goff = LAYER ? 1536 : 4608, ocol = LAYER ? 0 : 1024;
    const bf16* P = (const bf16*)(a.ws + WS_PROJ); const bf16* QP = (const bf16*)(a.ws + WS_QP); bf16* MIX = (bf16*)(a.ws + WS_H);
    const bf16* KL = (const bf16*)(a.ws + (LAYER ? WS_KL1 : WS_KL0)); const bf16* VL = (const bf16*)(a.ws + (LAYER ? WS_VL1 : WS_VL0));
    const bf16* KC = (const bf16*)(a.ws + WS_KC); const bf16* VC = (const bf16*)(a.ws + WS_VC);
    const float* sink = a.in[23];
    const att::lptr lds = (att::lptr)F.lds;
    const int per = (512 + F.G - 1) / F.G;
    for (int i = 0; i < per; ++i) {
        const int u = F.vcu * per + i; if (u >= 512) break;
        const int grp = u >> 5, g = (u >> 3) & 3, qb = u & 7, b = grp >> 1, kvh = grp & 1, h = kvh * 4 + g;
        const size_t row0 = (size_t)NCTX + (size_t)b * 2048 + qb * 256; const size_t ko = (size_t)b * (2560 * 256) + kvh * 128;
        const float m0 = LAYER ? sink[h] * LOG2E : -1e30f, l0 = LAYER ? 1.f : 0.f;
        if (LAYER == 0) att::attn_unit<0, 2>(QP + row0 * 1024 + h * 128, KL + ko, VL + ko, 40, 0, 0, m0, l0, P + row0 * ldc + goff + h * 128, ldc, MIX + row0 * DM + ocol + h * 128, lds);
        else { const int q0 = qb * 256, wsl = q0 >= 128 ? q0 - 128 : 0, wel = q0 + 384 <= 2048 ? q0 + 384 : 2048;
            att::attn_unit<1, 1>(QP + row0 * 1024 + h * 128, KL + ko, VL + ko, 8 + (wel - wsl) / 64, q0, wsl, m0, l0, P + row0 * ldc + goff + h * 128, ldc, MIX + row0 * DM + ocol + h * 128, lds); }
    }
    const int stride = F.G >= 256 ? F.G / 128 : 1;
    if (F.vcu % stride == 0) {
        for (int c = F.vcu / stride; c < 128; c += (F.G + stride - 1) / stride) {
            const int s = c >> 3, h = c & 7, kvh = h >> 2; const size_t row0 = (size_t)s * 256; const size_t ko = (size_t)s * 65536 + kvh * 128;
            const float m0 = LAYER ? sink[h] * LOG2E : -1e30f, l0 = LAYER ? 1.f : 0.f;
            att::attn_unit<0, 2>(QP + row0 * 1024 + h * 128, KC + ko, VC + ko, 4, 0, 0, m0, l0, P + row0 * ldc + goff + h * 128, ldc, MIX + row0 * DM + ocol + h * 128, lds);
        }
    }
}

__global__ void __launch_bounds__(NWAVES * 64, 2) mk_fwd(Args args) {
    extern __shared__ __attribute__((aligned(16))) unsigned char lds[];
    Frame F;
    F.lds = (LAS unsigned char*)lds;
    F.MISC = (volatile LAS unsigned*)(F.lds + MISC_OFF);
    F.tid = threadIdx.x; F.lane = F.tid & 63; F.wave = __builtin_amdgcn_readfirstlane(F.tid >> 6);
    F.G = gridDim.x; { const int bx = blockIdx.x; F.vcu = (F.G % 8 == 0) ? (bx % 8) * (F.G / 8) + bx / 8 : bx; }
    unsigned char* ws = args.ws;
    gu32* ctl = (gu32*)(ws + WS_CTL);
    for (int u = F.tid; u < (LDS_BYTES - LDSCTL_OFF) / 4; u += NWAVES * 64) ((LAS unsigned*)(F.lds + LDSCTL_OFF))[u] = 0u;
    __syncthreads();
    const int lo = args.ph_lo, hi = args.ph_hi;
    XcdBarrier bar; bar.bar = (unsigned*)(ctl + CW_BAR); bar.x = 0; bar.st = nullptr;
    if (hi - lo > 1) bar = xcd_barrier_post((unsigned*)(ctl + CW_BAR), F.MISC + 8);
#define IN(k) (lo <= (k) && (k) < hi)
#define SEAM(k) do { if (IN(k) && IN((k) + 1)) xcd_barrier(bar); } while (0)
    bf16* Hb = (bf16*)(ws + WS_H); bf16* PROJ = (bf16*)(ws + WS_PROJ);
    const float* MOD = (const float*)(ws + WS_MOD);

    if (IN(0)) { p0_prologue(F, args); } SEAM(0);
    if (IN(1)) { h_rows(F, args, 0, args.in[0], args.in[1], args.in[10]); } SEAM(1);
    if (IN(2)) {
        pg8::Gemm g{Hb, (const bf16*)(ws + WS_WIN0), MROWS, IN0, DM}; pg8::StaticOrder S; S.init(MROWS, IN0, F.G, (int)blockIdx.x);
        pg8::EpiProj E{PROJ, IN0, 17, args.out + OUT_V0, -1, nullptr};
        pg8::gemm_phase<pg8::EpiProj, pg8::StaticOrder, true, true>(F.lds, g, S, E);
    } SEAM(2);
    if (IN(3)) { conv0_items(F, args); prep_rows<0>(F, args); } SEAM(3);
    if (IN(4)) { attn_phase<0>(F, args); } SEAM(4);
    if (IN(5)) {
        pg8::Gemm g{Hb, (const bf16*)(ws + WS_WOUT0), MROWS, DM, DM}; pg8::StaticOrder S; S.init(MROWS, DM, F.G, (int)blockIdx.x);
        pg8::EpiRes E{args.in[0], args.in[1], args.out, MOD + 4096};
        pg8::gemm_phase<pg8::EpiRes, pg8::StaticOrder, true, true>(F.lds, g, S, E);
    } SEAM(5);
    if (IN(6)) { h_rows(F, args, 1, args.out, args.out + (size_t)NCTX * DM, args.in[21]); } SEAM(6);
    if (IN(7)) {
        pg8::Gemm g{Hb, (const bf16*)(ws + WS_WIN1), MROWS, IN1, DM}; pg8::StaticOrder S; S.init(MROWS, IN1, F.G, (int)blockIdx.x);
        pg8::EpiProj E{PROJ, IN1, 4, args.out + OUT_K1, 5, args.out + OUT_V1};
        pg8::gemm_phase<pg8::EpiProj, pg8::StaticOrder, true, true>(F.lds, g, S, E);
    } SEAM(7);
    if (IN(8)) { conv1_rows(F, args); prep_rows<1>(F, args); } SEAM(8);
    if (IN(9)) { attn_phase<1>(F, args); } SEAM(9);
    if (IN(10)) {
        pg8::Gemm g{Hb, (const bf16*)(ws + WS_WOUT1), MROWS, DM, DM}; pg8::StaticOrder S; S.init(MROWS, DM, F.G, (int)blockIdx.x);
        pg8::EpiRes E{args.out, args.out + (size_t)NCTX * DM, args.out, MOD + 9 * 6144 + 4096};
        pg8::gemm_phase<pg8::EpiRes, pg8::StaticOrder, true, true>(F.lds, g, S, E);
    } SEAM(10);
    if (IN(11)) { final_rows(F, args); }
#undef IN
#undef SEAM
}

extern "C" void kernel_launch(void* const* d_in, const int* in_sizes, int n_in, void* d_out, int out_size, void* d_ws, size_t ws_size, hipStream_t stream) {
    static int grid = 0;
    if (grid == 0) {
        if (n_in != 27 || out_size != (int)(OUT_K0 + 4 * 1048576) || ws_size < WS_END) { fprintf(stderr, "kernel_launch: unexpected problem shape: n_in %d out %d ws %zu; nothing launched\n", n_in, out_size, ws_size); grid = -1; return; }
        int dev = 0, cus = 0;
        if (hipGetDevice(&dev) != hipSuccess || hipDeviceGetAttribute(&cus, hipDeviceAttributeMultiprocessorCount, dev) != hipSuccess) { grid = -1; return; }
        if (hipFuncSetAttribute((const void*)mk_fwd, hipFuncAttributeMaxDynamicSharedMemorySize, LDS_BYTES) != hipSuccess) { fprintf(stderr, "kernel_launch: hipFuncSetAttribute failed\n"); grid = -1; return; }
        int per_cu = 0;
        if (hipOccupancyMaxActiveBlocksPerMultiprocessor(&per_cu, (const void*)mk_fwd, NWAVES * 64, LDS_BYTES) != hipSuccess || per_cu < 1) fprintf(stderr, "kernel_launch: note: occupancy query reports %d workgroups per CU\n", per_cu);
        (void)hipGetLastError();
        grid = cus;
    }
    if (grid < 0) return;
    if (hipMemsetAsync((char*)d_ws + WS_CTL, 0, CTL_ZERO_BYTES, stream) != hipSuccess) { fprintf(stderr, "kernel_launch: hipMemsetAsync failed\n"); return; }
    Args a{};
    for (int i = 0; i < 27; ++i) a.in[i] = (const float*)d_in[i];
    a.out = (float*)d_out; a.ws = (unsigned char*)d_ws;
#if MK_N_LAUNCHES == 1
    a.ph_lo = 0; a.ph_hi = NPH;
    hipLaunchKernelGGL(mk_fwd, dim3(grid), dim3(NWAVES * 64), LDS_BYTES, stream, a);
#else
    for (int p = 0; p < NPH; ++p) { a.ph_lo = p; a.ph_hi = p + 1; hipLaunchKernelGGL(mk_fwd, dim3(grid), dim3(NWAVES * 64), LDS_BYTES, stream, a); }
#endif
    const hipError_t le = hipPeekAtLastError();
    if (le != hipSuccess) fprintf(stderr, "kernel_launch: launch failed: %s\n", hipGetErrorName(le));
}
```

```cpp
#include <hip/hip_runtime.h>
#include <cstdio>
#include <cstdint>
namespace pg8 {
#define PG8_LAS __attribute__((address_space(3)))
typedef unsigned short bf16_t;
typedef short bf16x8 __attribute__((ext_vector_type(8)));
typedef float f32x4 __attribute__((ext_vector_type(4)));
typedef unsigned u32x4 __attribute__((ext_vector_type(4)));
constexpr int BM = 256, BK = 64, HALF = 128, HTB = HALF * BK * 2  , STAGE_BYTES = 8 * HTB, NXCD = 8, WGM = 8;

__host__ __device__ __forceinline__ int lds_byte(int r, int c) { const int st = (r >> 4) * 2 + (c >> 5), rr = r & 15, cc = c & 31, ob = rr * 64 + cc * 2; return st * 1024 + (ob ^ (((ob >> 9) & 1) << 5)); }
__host__ __device__ __forceinline__ void stage_rc(int b, int& R, int& C) { const int st = b / 1024, sb = b % 1024, swz = sb ^ (((sb >> 9) & 1) << 5); R = (st >> 1) * 16 + swz / 64; C = (st & 1) * 32 + (swz % 64) / 2; }
__host__ __device__ __forceinline__ int perm32(int rho) { const int n = rho >> 4, i = rho & 15; return 8 * (i >> 2) + 4 * n + (i & 3); }

struct Unit { int pm, pn; };
struct Gemm { const bf16_t* A; const bf16_t* Bt; int M, N, K; };

struct StaticOrder {
    int nM, nN, nwg, G, c;
    __host__ __device__ void init(int M, int N, int G_, int c_) { nM = M / BM; nN = N / BM; nwg = nM * nN; G = G_; c = c_; }
    __host__ __device__ bool next(int i, Unit& u) const {
        const long L = (long)i * G + c; if (L >= nwg) return false;
        int wgid = (int)L; { const int q = nwg / NXCD, r = nwg % NXCD, xcd = wgid % NXCD, off = wgid / NXCD; wgid = (xcd < r ? xcd * (q + 1) : r * (q + 1) + (xcd - r) * q) + off; }
        const int nig = WGM * nN, gid = wgid / nig, fm = gid * WGM, gsz = (nM - fm) < WGM ? (nM - fm) : WGM;
        u.pm = fm + ((wgid % nig) % gsz); u.pn = (wgid % nig) / gsz; return true;
    }
    __device__ __forceinline__ void a_ready(const Unit&) const {}
    __device__ __forceinline__ void done(const Unit&) const {}
};

__device__ __forceinline__ unsigned cvt_pk_bf16(float lo, float hi) { unsigned r; asm volatile("v_cvt_pk_bf16_f32 %0, %1, %2" : "=v"(r) : "v"(lo), "v"(hi)); return r; }
typedef float f32x2 __attribute__((ext_vector_type(2)));
struct EpiProj {
    static constexpr bool PERM = true, AFTER_DRAIN = false;
    bf16_t* O; int ldc; int pair_lo, pair_hi, pair_kind; int pn_v; bf16_t* VL; bf16_t* VC; float* out_v; int pn_k; bf16_t* KC; float* out_k;
    __device__ __forceinline__ void operator()(const f32x4 (&acc)[2][2][4][2], const Unit& u, int wr, int wc, int fr, int fq) const {
        const int row0 = u.pm * BM + wr * 64 + fr, cl = wc * 32 + 8 * fq;
        if (u.pn >= pair_lo && u.pn < pair_hi) {
            bf16_t* ob = O + pair_lo * 256 + (u.pn - pair_lo) * 128 + cl;
#pragma unroll
            for (int ai = 0; ai < 2; ++ai)
#pragma unroll
                for (int m = 0; m < 4; ++m) { f32x4 r0, r1; const f32x4 a0 = acc[ai][0][m][0], a1 = acc[ai][0][m][1], b0 = acc[ai][1][m][0], b1 = acc[ai][1][m][1];
                    if (pair_kind == 0) {
#pragma unroll
                        for (int e = 0; e < 4; ++e) { r0[e] = a0[e] * __builtin_amdgcn_rcpf(1.0f + __expf(-b0[e])); r1[e] = a1[e] * __builtin_amdgcn_rcpf(1.0f + __expf(-b1[e])); }
                    } else { r0 = a0 * b0; r1 = a1 * b1; }
                    u32x4 w; w.x = cvt_pk_bf16(r0[0], r0[1]); w.y = cvt_pk_bf16(r0[2], r0[3]); w.z = cvt_pk_bf16(r1[0], r1[1]); w.w = cvt_pk_bf16(r1[2], r1[3]);
                    *(u32x4*)(ob + (size_t)(row0 + ai * HALF + m * 16) * ldc) = w; }
            return;
        }
        if (u.pn == pn_v) {
            const bool ctx = u.pm < 16;
            bf16_t* vb = ctx ? VC : VL + (ptrdiff_t)(512 * (((u.pm - 16) >> 3) + 1) - 4096) * 256;
#pragma unroll
            for (int ai = 0; ai < 2; ++ai)
#pragma unroll
                for (int m = 0; m < 4; ++m) { const size_t r = (size_t)(row0 + ai * HALF + m * 16);
#pragma unroll
                    for (int bj = 0; bj < 2; ++bj) { const f32x4 v0 = acc[ai][bj][m][0], v1 = acc[ai][bj][m][1];
                        u32x4 w; w.x = cvt_pk_bf16(v0[0], v0[1]); w.y = cvt_pk_bf16(v0[2], v0[3]); w.z = cvt_pk_bf16(v1[0], v1[1]); w.w = cvt_pk_bf16(v1[2], v1[3]);
                        *(u32x4*)(vb + r * 256 + bj * HALF + cl) = w;
                        if (ctx) { *(f32x4*)(out_v + r * 256 + bj * HALF + cl) = v0; *(f32x4*)(out_v + r * 256 + bj * HALF + cl + 4) = v1; } } }
            return;
        }
        const int oc = (u.pn < pair_lo ? u.pn * 256 : u.pn * 256 - (pair_hi - pair_lo) * 128) + cl;
        const bool kctx = (u.pn == pn_k) && (u.pm < 16);
#pragma unroll
        for (int ai = 0; ai < 2; ++ai)
#pragma unroll
            for (int m = 0; m < 4; ++m) { const size_t r = (size_t)(row0 + ai * HALF + m * 16);
#pragma unroll
                for (int bj = 0; bj < 2; ++bj) { const f32x4 v0 = acc[ai][bj][m][0], v1 = acc[ai][bj][m][1];
                    u32x4 w; w.x = cvt_pk_bf16(v0[0], v0[1]); w.y = cvt_pk_bf16(v0[2], v0[3]); w.z = cvt_pk_bf16(v1[0], v1[1]); w.w = cvt_pk_bf16(v1[2], v1[3]);
                    *(u32x4*)(O + r * ldc + oc + bj * HALF) = w;
                    if (kctx) { *(u32x4*)(KC + r * 256 + bj * HALF + cl) = w; *(f32x4*)(out_k + r * 256 + bj * HALF + cl) = v0; *(f32x4*)(out_k + r * 256 + bj * HALF + cl + 4) = v1; } } }
    }
};
struct EpiRes {
    static constexpr bool PERM = false, AFTER_DRAIN = false;
    const float* xp; const float* xs; float* out; const float* gate;
    __device__ __forceinline__ void operator()(const f32x4 (&acc)[2][2][4][2], const Unit& u, int wr, int wc, int fr, int fq) const {
        const int row0 = u.pm * BM + wr * 64 + fr, col0 = u.pn * BM + wc * 32 + 4 * fq;
        const int cr = u.pm < 16 ? 8 : ((u.pm - 16) >> 3);
        const float* g = gate + (size_t)cr * 6144 + col0;
        f32x4 gv[2][2];
#pragma unroll
        for (int bj = 0; bj < 2; ++bj)
#pragma unroll
            for (int n = 0; n < 2; ++n) gv[bj][n] = *(const f32x4*)(g + bj * HALF + n * 16);
#pragma unroll
        for (int ai = 0; ai < 2; ++ai)
#pragma unroll
            for (int m = 0; m < 4; ++m) { const int r = row0 + ai * HALF + m * 16;
                const float* base = (u.pm < 16 ? xp + (size_t)r * 2048 : xs + (size_t)(r - 4096) * 2048) + col0;
                float* o = out + (size_t)r * 2048 + col0;
#pragma unroll
                for (int bj = 0; bj < 2; ++bj)
#pragma unroll
                    for (int n = 0; n < 2; ++n) { const f32x4 bs = *(const f32x4*)(base + bj * HALF + n * 16); *(f32x4*)(o + bj * HALF + n * 16) = bs + gv[bj][n] * acc[ai][bj][m][n]; }
                if (m & 1) asm volatile("" ::: "memory"); }
    }
};

template <class Epi, class Sched, bool ALIGN_EPI = false, bool SP2 = false>
__device__ __forceinline__ void gemm_phase(PG8_LAS unsigned char* lds, const Gemm g, const Sched& S, const Epi& E) {
    int tid_ = threadIdx.x; asm volatile("" : "+v"(tid_));
    const int tid = tid_, wid = __builtin_amdgcn_readfirstlane(tid >> 6), lane = tid & 63, wr = wid >> 2, wc = wid & 3, fr = lane & 15, fq = lane >> 4;
    const int K = g.K, nt = K / BK;
    unsigned voffA[2], voffB[2];
#pragma unroll
    for (int i = 0; i < 2; ++i) { int R, C; stage_rc(tid * 16 + i * 8192, R, C); const int Rb = Epi::PERM ? ((R & ~31) + perm32(R & 31)) : R;
        voffA[i] = (unsigned)(R * K + C) * 2u; voffB[i] = (unsigned)(Rb * K + C) * 2u; }
    const size_t kstep = (size_t)(BK * 2);
    const size_t hstep = (size_t)HALF * K * 2;
    const size_t tstep = 2 * hstep;
    const unsigned ldsw = (unsigned)wid * 1024u;
    const int aoff = lds_byte(wr * 64 + fr, fq * 8), boff = lds_byte(wc * 32 + fr, fq * 8);
#define PG8_SA(b, h) (((b) * 2 + (h)) * HTB)
#define PG8_SB(b, h) ((4 + (b) * 2 + (h)) * HTB)
#define PG8_STAGE(bufoff, gbase, voff) do { _Pragma("unroll") for (int _i = 0; _i < 2; ++_i) \
        __builtin_amdgcn_global_load_lds((const unsigned*)((const char*)(gbase) + (voff)[_i]), (PG8_LAS unsigned*)(lds + (bufoff) + ldsw + _i * 8192), 16, 0, 0); } while (0)
#define PG8_LDA(dst, b, h) do { _Pragma("unroll") for (int m = 0; m < 4; ++m) _Pragma("unroll") for (int k = 0; k < 2; ++k) dst[m][k] = *(const PG8_LAS bf16x8*)(lds + PG8_SA(b, h) + aoff + m * 2048 + k * 1024); } while (0)
#define PG8_LDB(dst, b, h) do { _Pragma("unroll") for (int n = 0; n < 2; ++n) _Pragma("unroll") for (int k = 0; k < 2; ++k) dst[n][k] = *(const PG8_LAS bf16x8*)(lds + PG8_SB(b, h) + boff + n * 2048 + k * 1024); } while (0)
#define PG8_MMA(ai, bj, At, Bt) do { __builtin_amdgcn_s_setprio(1); _Pragma("unroll") for (int m = 0; m < 4; ++m) _Pragma("unroll") for (int n = 0; n < 2; ++n) _Pragma("unroll") for (int k = 0; k < 2; ++k) \
        acc[ai][bj][m][n] = __builtin_amdgcn_mfma_f32_16x16x32_bf16(Bt[n][k], At[m][k], acc[ai][bj][m][n], 0, 0, 0); __builtin_amdgcn_s_setprio(0); } while (0)
#define PG8_WAIT_V(n) asm volatile("s_waitcnt vmcnt(" #n ")" ::: "memory")
#define PG8_WAIT_L(n) asm volatile("s_waitcnt lgkmcnt(" #n ")" ::: "memory")
#define PG8_BAR __builtin_amdgcn_s_barrier()
#define PG8_SCHED __builtin_amdgcn_sched_barrier(0)
    Unit cur, nxt; int ui = 0;
    if (!S.next(0, cur)) return;
    f32x4 acc[2][2][4][2];
#pragma unroll
    for (int a = 0; a < 2; ++a)
#pragma unroll
        for (int b = 0; b < 2; ++b)
#pragma unroll
            for (int m = 0; m < 4; ++m)
#pragma unroll
                for (int n = 0; n < 2; ++n) acc[a][b][m][n] = (f32x4){0.f, 0.f, 0.f, 0.f};
    bf16x8 At[4][2], B0[2][2], B1[2][2];
    const char* cA = (const char*)g.A + (size_t)cur.pm * tstep; const char* cB = (const char*)g.Bt + (size_t)cur.pn * tstep;
    S.a_ready(cur);
    if constexpr (SP2) {
        PG8_STAGE(PG8_SB(0, 0), cB, voffB); PG8_STAGE(PG8_SB(0, 1), cB + hstep, voffB); PG8_STAGE(PG8_SA(0, 0), cA, voffA); PG8_STAGE(PG8_SA(0, 1), cA + hstep, voffA);
        if (wr == 1) PG8_BAR;
        PG8_WAIT_V(2); PG8_BAR;
        PG8_STAGE(PG8_SB(1, 0), cB + kstep, voffB); PG8_STAGE(PG8_SA(1, 0), cA + kstep, voffA); PG8_STAGE(PG8_SB(1, 1), cB + hstep + kstep, voffB);
        PG8_WAIT_V(6); PG8_BAR;
    } else {
        PG8_STAGE(PG8_SB(0, 0), cB, voffB); PG8_STAGE(PG8_SA(0, 0), cA, voffA); PG8_STAGE(PG8_SB(0, 1), cB + hstep, voffB); PG8_STAGE(PG8_SA(0, 1), cA + hstep, voffA);
        if (wr == 1) PG8_BAR;
        PG8_WAIT_V(4); PG8_BAR;
        PG8_STAGE(PG8_SB(1, 0), cB + kstep, voffB); PG8_STAGE(PG8_SA(1, 0), cA + kstep, voffA); PG8_STAGE(PG8_SB(1, 1), cB + hstep + kstep, voffB);
        PG8_WAIT_V(6); PG8_BAR;
    }
    for (;;) {
        const bool has_next = S.next(ui + 1, nxt);
        const char* nA = has_next ? (const char*)g.A + (size_t)nxt.pm * tstep : cA; const char* nB = has_next ? (const char*)g.Bt + (size_t)nxt.pn * tstep : cB;
        for (int t = 0; t < nt; t += 2) {
            const bool last = (t == nt - 2);
            const char* a1 = cA + (size_t)(t + 1) * kstep;
            const char* a2 = last ? nA : cA + (size_t)(t + 2) * kstep; const char* b2 = last ? nB : cB + (size_t)(t + 2) * kstep;
            const char* a3 = a2 + kstep; const char* b3 = b2 + kstep;
            if (last && has_next) S.a_ready(nxt);
            if constexpr (SP2) {
            PG8_LDB(B0, 0, 0); PG8_LDB(B1, 0, 1); PG8_SCHED; PG8_LDA(At, 0, 0); PG8_STAGE(PG8_SA(1, 1), a1 + hstep, voffA);
            PG8_WAIT_V(8); PG8_WAIT_L(0); PG8_BAR; PG8_MMA(0, 0, At, B0); PG8_MMA(0, 1, At, B1); PG8_BAR; PG8_SCHED;
            PG8_LDA(At, 0, 1); PG8_STAGE(PG8_SB(0, 0), b2, voffB); PG8_STAGE(PG8_SB(0, 1), b2 + hstep, voffB); PG8_STAGE(PG8_SA(0, 0), a2, voffA);
            PG8_WAIT_V(8); PG8_WAIT_L(0); PG8_BAR; PG8_MMA(1, 0, At, B0); PG8_MMA(1, 1, At, B1); PG8_BAR; PG8_SCHED;
            PG8_LDB(B0, 1, 0); PG8_LDB(B1, 1, 1); PG8_SCHED; PG8_LDA(At, 1, 0); PG8_STAGE(PG8_SA(0, 1), a2 + hstep, voffA);
            PG8_WAIT_V(8); PG8_WAIT_L(0); PG8_BAR; PG8_MMA(0, 0, At, B0); PG8_MMA(0, 1, At, B1); PG8_BAR; PG8_SCHED;
            PG8_LDA(At, 1, 1); PG8_STAGE(PG8_SB(1, 0), b3, voffB); PG8_STAGE(PG8_SB(1, 1), b3 + hstep, voffB); PG8_STAGE(PG8_SA(1, 0), a3, voffA);
            PG8_WAIT_V(8); PG8_WAIT_L(0); PG8_BAR; PG8_MMA(1, 0, At, B0); PG8_MMA(1, 1, At, B1); PG8_BAR; PG8_SCHED;
            } else {
            PG8_LDB(B0, 0, 0); PG8_SCHED; PG8_LDA(At, 0, 0); PG8_STAGE(PG8_SA(1, 1), a1 + hstep, voffA);
            PG8_WAIT_L(8); PG8_BAR; PG8_WAIT_L(0); PG8_MMA(0, 0, At, B0); PG8_BAR; PG8_SCHED;
            PG8_LDB(B1, 0, 1); PG8_STAGE(PG8_SB(0, 0), b2, voffB);
            PG8_BAR; PG8_WAIT_L(0); PG8_MMA(0, 1, At, B1); PG8_BAR;
            PG8_LDA(At, 0, 1); PG8_STAGE(PG8_SA(0, 0), a2, voffA);
            PG8_BAR; PG8_WAIT_L(0); PG8_MMA(1, 0, At, B0); PG8_BAR; PG8_SCHED;
            PG8_STAGE(PG8_SB(0, 1), b2 + hstep, voffB);
            PG8_WAIT_V(6); PG8_BAR; PG8_MMA(1, 1, At, B1); PG8_BAR;
            PG8_LDB(B0, 1, 0); PG8_SCHED; PG8_LDA(At, 1, 0); PG8_STAGE(PG8_SA(0, 1), a2 + hstep, voffA);
            PG8_WAIT_L(8); PG8_BAR; PG8_WAIT_L(0); PG8_MMA(0, 0, At, B0); PG8_BAR; PG8_SCHED;
            PG8_LDB(B1, 1, 1); PG8_STAGE(PG8_SB(1, 0), b3, voffB);
            PG8_BAR; PG8_WAIT_L(0); PG8_MMA(0, 1, At, B1); PG8_BAR;
            PG8_LDA(At, 1, 1); PG8_STAGE(PG8_SA(1, 0), a3, voffA);
            PG8_BAR; PG8_WAIT_L(0); PG8_MMA(1, 0, At, B0); PG8_BAR; PG8_SCHED;
            PG8_STAGE(PG8_SB(1, 1), b3 + hstep, voffB);
            PG8_WAIT_V(6); PG8_BAR; PG8_MMA(1, 1, At, B1); PG8_BAR;
            }
        }
        if constexpr (ALIGN_EPI) { if (wr == 0) PG8_BAR; }
        if constexpr (!Epi::AFTER_DRAIN) { E(acc, cur, wr, wc, fr, fq); S.done(cur); }
        if (!has_next) break;
#pragma unroll
        for (int a = 0; a < 2; ++a)
#pragma unroll
            for (int b = 0; b < 2; ++b)
#pragma unroll
                for (int m = 0; m < 4; ++m)
#pragma unroll
                    for (int n = 0; n < 2; ++n) acc[a][b][m][n] = (f32x4){0.f, 0.f, 0.f, 0.f};
        cur = nxt; cA = nA; cB = nB; ++ui;
        if constexpr (ALIGN_EPI) { if (wr == 1) PG8_BAR; }
    }
    PG8_WAIT_V(0);
    if constexpr (!ALIGN_EPI) { if (wr == 0) PG8_BAR; }
    PG8_BAR;
    if constexpr (Epi::AFTER_DRAIN) { E.fused(acc, cur, wr, wc, fr, fq, lds, wid, lane); S.done(cur); }
#undef PG8_SA
#undef PG8_SB
#undef PG8_STAGE
#undef PG8_LDA
#undef PG8_LDB
#undef PG8_MMA
#undef PG8_WAIT_V
#undef PG8_WAIT_L
#undef PG8_BAR
#undef PG8_SCHED
}
}

#define GAS __attribute__((address_space(1)))
#define LAS __attribute__((address_space(3)))
typedef unsigned short bf16;
typedef unsigned v4u __attribute__((ext_vector_type(4)));
typedef float f32x4 __attribute__((ext_vector_type(4)));
typedef short bf16x8 __attribute__((ext_vector_type(8)));
typedef GAS unsigned gu32;
typedef GAS unsigned long long gu64;
#define RLX_AGENT __ATOMIC_RELAXED, __HIP_MEMORY_SCOPE_AGENT
#define LDS_WAIT() asm volatile("s_waitcnt lgkmcnt(0)" ::: "memory")
#define VM_WAIT() asm volatile("s_waitcnt vmcnt(0)" ::: "memory")
__device__ __forceinline__ unsigned long long rt() { return __builtin_amdgcn_s_memrealtime(); }
__device__ __forceinline__ unsigned f2bf(float f) { unsigned u = __builtin_bit_cast(unsigned, f); return (u + 0x7fffu + ((u >> 16) & 1u)) >> 16; }
__device__ __forceinline__ unsigned pk2(float lo, float hi) { return f2bf(lo) | (f2bf(hi) << 16); }

#define XB_TMO      128
#define XB_XCNT(j)  (256  + 64 * (j))
#define XB_XSUB(j)  (1280 + 64 * (j))
#define XB_XGEN(j)  (2304 + 64 * (j))
#define XB_TOP      3328
#define XB_TOPGEN   3392
#define XCD_BAR_WORDS 3456
#define XB_SPIN_CAP (1u << 18)

__device__ __forceinline__ unsigned xb_ld(unsigned* p)              { return __hip_atomic_load(p, __ATOMIC_RELAXED, __HIP_MEMORY_SCOPE_AGENT); }
__device__ __forceinline__ unsigned xb_add(unsigned* p, unsigned v) { return __hip_atomic_fetch_add(p, v, __ATOMIC_RELAXED, __HIP_MEMORY_SCOPE_AGENT); }
__device__ __forceinline__ unsigned xb_xcc_id() { return (unsigned)__builtin_amdgcn_s_getreg((3 << 11) | 20) & 0xFu; }
#define XB_SPIN(cond, bar) do { unsigned _sp = 0; while (cond) { __builtin_amdgcn_s_sleep(1); \
    if ((++_sp & 255u) == 0u) { if (xb_ld(&(bar)[XB_TMO])) break; if (_sp > XB_SPIN_CAP) { atomicAdd(&(bar)[XB_TMO], 1u); break; } } } } while (0)

struct XcdBarrier {
    unsigned* bar; unsigned x;
    volatile LAS unsigned* st;
};

__device__ __forceinline__ XcdBarrier xcd_barrier_post(unsigned* bar, volatile LAS unsigned* st) {
    XcdBarrier b; b.bar = bar; b.x = xb_xcc_id(); b.st = st;
    if (threadIdx.x == 0) (void)xb_add(&bar[XB_XCNT(b.x)], 1u);
    return b;
}
__device__ __forceinline__ void xcd_barrier_complete(unsigned* bar, unsigned x, unsigned& nloc, unsigned& nx) {
    const unsigned G = gridDim.x * gridDim.y * gridDim.z;
    unsigned sum, cnt, mine, sp = 0u;
    for (;;) {
        sum = 0u; cnt = 0u; mine = 0u;
#pragma unroll
        for (unsigned j = 0; j < 16; ++j) { const unsigned c = xb_ld(&bar[XB_XCNT(j)]); sum += c; cnt += (c > 0u) ? 1u : 0u; mine = (j == x) ? c : mine; }
        if (sum == G) break;
        __builtin_amdgcn_s_sleep(1);
        if ((++sp & 255u) == 0u) { if (xb_ld(&bar[XB_TMO])) break; if (sp > XB_SPIN_CAP) { atomicAdd(&bar[XB_TMO], 1u); break; } }
    }
    nloc = mine > 0u ? mine : 1u; nx = cnt > 0u ? cnt : 1u;
}

__device__ __forceinline__ void xcd_barrier(const XcdBarrier& b) {
    asm volatile("s_waitcnt vmcnt(0)" ::: "memory");
    __syncthreads();
    if (threadIdx.x == 0) {
        unsigned* bar = b.bar;
        __builtin_amdgcn_s_waitcnt(0);
        unsigned nloc = b.st[0], nx = b.st[1];
        if (nloc == 0u) { xcd_barrier_complete(bar, b.x, nloc, nx); b.st[0] = nloc; b.st[1] = nx; }
        const unsigned old = xb_add(&bar[XB_XSUB(b.x)], 1u);
        const unsigned gen = old / nloc;
        if (old + 1u == (gen + 1u) * nloc) {
            __builtin_amdgcn_fence(__ATOMIC_RELEASE, "agent");
            asm volatile("s_waitcnt vmcnt(0)" ::: "memory");
            const unsigned og = xb_add(&bar[XB_TOP], 1u);
            const unsigned tg = og / nx;
            if (og + 1u == (tg + 1u) * nx) xb_add(&bar[XB_TOPGEN], 1u);
            else XB_SPIN(xb_ld(&bar[XB_TOPGEN]) == tg, bar);
            __builtin_amdgcn_fence(__ATOMIC_ACQUIRE, "agent");
            xb_add(&bar[XB_XGEN(b.x)], 1u);
            asm volatile("s_waitcnt vmcnt(0)" ::: "memory");
        } else {
            XB_SPIN(xb_ld(&bar[XB_XGEN(b.x)]) == gen, bar);
            __builtin_amdgcn_fence(__ATOMIC_ACQUIRE, "agent");
            asm volatile("s_waitcnt vmcnt(0)" ::: "memory");
        }
    }
    __syncthreads();
}

typedef float f32x2 __attribute__((ext_vector_type(2)));
namespace att {
using bf16x8 = __attribute__((ext_vector_type(8))) short;
using s16x4  = __attribute__((ext_vector_type(4))) short;
using f32x16 = __attribute__((ext_vector_type(16))) float;
using u32x4  = __attribute__((ext_vector_type(4))) unsigned;
typedef __attribute__((address_space(3))) char* lptr;
typedef __attribute__((address_space(3))) const char* lcptr;
constexpr int NW = 8, QBLK = 32, KVBLK = 64, LDK = 256;
constexpr float QS = 0.08838834764831845f * 1.4426950408889634f;
constexpr float THRL = 8.f;
constexpr int SHM_V = 16384, SHM_K = 16384, OFF_K = 2 * SHM_V, OFF_WS = 2 * SHM_V + 2 * SHM_K, OFF_STG = OFF_WS + NW * 64 * 4, STG_ROW = 272, STG_WAVE = 32 * STG_ROW;
constexpr int ATT_LDS = OFF_STG + NW * STG_WAVE;
#define KSWZ(row, colB) ((row) * 256 + ((colB) ^ (((row) & 7) << 4)))
#define SBAR() __builtin_amdgcn_sched_barrier(0)
__device__ __forceinline__ int crow(int r, int hi) { return (r & 3) + 8 * (r >> 2) + 4 * hi; }
__device__ __forceinline__ unsigned cvtpk(float lo, float hi) { unsigned r; asm volatile("v_cvt_pk_bf16_f32 %0, %1, %2" : "=v"(r) : "v"(lo), "v"(hi)); return r; }

__device__ __forceinline__ void partialSM(f32x16& p0, f32x16& p1, float& m_reg, float& mn, float& alpha) {
  float pmax = p0[0];
#pragma unroll
  for (int r = 1; r < 16; ++r) pmax = fmaxf(pmax, p0[r]);
#pragma unroll
  for (int r = 0; r < 16; ++r) pmax = fmaxf(pmax, p1[r]);
  { auto rr = __builtin_amdgcn_permlane32_swap(__float_as_uint(pmax), __float_as_uint(pmax), false, false);
    pmax = fmaxf(__uint_as_float(rr[0]), __uint_as_float(rr[1])); }
  if (__builtin_expect(__all(pmax - m_reg <= THRL), 1)) { mn = m_reg; alpha = 1.f; }
  else { mn = fmaxf(m_reg, pmax); alpha = __builtin_amdgcn_exp2f(m_reg - mn); m_reg = mn; }
#pragma unroll
  for (int r = 0; r < 16; ++r) { p0[r] -= mn; p1[r] -= mn; }
#pragma unroll
  for (int r = 0; r < 16; ++r) p0[r] = __builtin_amdgcn_exp2f(p0[r]);
}
__device__ __forceinline__ void finishSM(f32x16& p0, f32x16& p1, float alpha, float& l_reg, bf16x8& pa0, bf16x8& pa1, bf16x8& pa2, bf16x8& pa3) {
#pragma unroll
  for (int r = 0; r < 16; ++r) p1[r] = __builtin_amdgcn_exp2f(p1[r]);
  float ps = 0;
#pragma unroll
  for (int r = 0; r < 16; ++r) ps += p0[r];
#pragma unroll
  for (int r = 0; r < 16; ++r) ps += p1[r];
  { auto rr = __builtin_amdgcn_permlane32_swap(__float_as_uint(ps), __float_as_uint(ps), false, false);
    ps = __uint_as_float(rr[0]) + __uint_as_float(rr[1]); }
  l_reg = l_reg * alpha + ps;
#define PK4(P, BASE, OUT) do { unsigned a0 = cvtpk(P[BASE + 0], P[BASE + 1]), a1 = cvtpk(P[BASE + 2], P[BASE + 3]);   \
    unsigned b0 = cvtpk(P[BASE + 4], P[BASE + 5]), b1 = cvtpk(P[BASE + 6], P[BASE + 7]);                              \
    auto r0 = __builtin_amdgcn_permlane32_swap(a0, b0, false, false); auto r1 = __builtin_amdgcn_permlane32_swap(a1, b1, false, false); \
    u32x4 w = {r0[0], r1[0], r0[1], r1[1]}; OUT = __builtin_bit_cast(bf16x8, w); } while (0)
  PK4(p0, 0, pa0); PK4(p0, 8, pa1); PK4(p1, 0, pa2); PK4(p1, 8, pa3);
#undef PK4
}
__device__ __forceinline__ void qkt(f32x16& p0, f32x16& p1, lcptr Ks, const bf16x8* qr, int r32, int hi) {
  p0 = f32x16{}; p1 = f32x16{};
#pragma unroll
  for (int d0 = 0; d0 < 8; ++d0) { const int cb = (d0 * 16 + hi * 8) * 2;
    const bf16x8 b0 = *(const __attribute__((address_space(3))) bf16x8*)(Ks + KSWZ(r32, cb));
    const bf16x8 b1 = *(const __attribute__((address_space(3))) bf16x8*)(Ks + KSWZ(32 + r32, cb));
    p0 = __builtin_amdgcn_mfma_f32_32x32x16_bf16(b0, qr[d0], p0, 0, 0, 0);
    p1 = __builtin_amdgcn_mfma_f32_32x32x16_bf16(b1, qr[d0], p1, 0, 0, 0); }
}
__device__ __forceinline__ int v_st(int k, int c) { const int kk = (k & ~0xC) | ((k & 4) << 1) | ((k & 8) >> 1); return ((kk >> 3) * 4 + (c >> 5)) * 512 + ((kk & 7) * 32 + (c & 31)) * 2; }
__device__ __forceinline__ int v_rd_base(int lane) { return ((lane & 3) << 3) | (((lane >> 2) & 3) << 6) | (((lane >> 4) & 1) << 5) | (((lane >> 5) & 1) << 8); }
constexpr int v_rd_off(int d0, int ks, int half) { return d0 * 512 + ks * 4096 + half * 2048; }
template <int OFF> __device__ __forceinline__ s16x4 tr_read(int vb) {
  s16x4 r; asm volatile("ds_read_b64_tr_b16 %0, %1 offset:%2" : "=&v"(r) : "v"(vb), "i"(OFF) : "memory"); return r;
}
template <int D0> __device__ __forceinline__ void pv_one(f32x16& od, int vb, bf16x8 pa0, bf16x8 pa1, bf16x8 pa2, bf16x8 pa3) {
  const s16x4 l0 = tr_read<v_rd_off(D0, 0, 0)>(vb), h0 = tr_read<v_rd_off(D0, 0, 1)>(vb), l1 = tr_read<v_rd_off(D0, 1, 0)>(vb), h1 = tr_read<v_rd_off(D0, 1, 1)>(vb);
  const s16x4 l2 = tr_read<v_rd_off(D0, 2, 0)>(vb), h2 = tr_read<v_rd_off(D0, 2, 1)>(vb), l3 = tr_read<v_rd_off(D0, 3, 0)>(vb), h3 = tr_read<v_rd_off(D0, 3, 1)>(vb);
  asm volatile("s_waitcnt lgkmcnt(0)" ::: "memory"); SBAR();
#define PK(L, H) (bf16x8){L[0], L[1], L[2], L[3], H[0], H[1], H[2], H[3]}
  od = __builtin_amdgcn_mfma_f32_32x32x16_bf16(pa0, PK(l0, h0), od, 0, 0, 0);
  od = __builtin_amdgcn_mfma_f32_32x32x16_bf16(pa1, PK(l1, h1), od, 0, 0, 0);
  od = __builtin_amdgcn_mfma_f32_32x32x16_bf16(pa2, PK(l2, h2), od, 0, 0, 0);
  od = __builtin_amdgcn_mfma_f32_32x32x16_bf16(pa3, PK(l3, h3), od, 0, 0, 0);
#undef PK
}
__device__ __forceinline__ void pv_d0(f32x16* o, int vb, bf16x8 pa0, bf16x8 pa1, bf16x8 pa2, bf16x8 pa3) {
  pv_one<0>(o[0], vb, pa0, pa1, pa2, pa3); pv_one<1>(o[1], vb, pa0, pa1, pa2, pa3); pv_one<2>(o[2], vb, pa0, pa1, pa2, pa3); pv_one<3>(o[3], vb, pa0, pa1, pa2, pa3);
}
__device__ __forceinline__ void wmask(f32x16& p0, f32x16& p1, int qpos, int kpos0, int hi) {
#pragma unroll
  for (int r = 0; r < 16; ++r) { const int d = qpos - (kpos0 + crow(r, hi)); if (d > 128 || d < -128) p0[r] = -1e30f; const int d1 = d - 32; if (d1 > 128 || d1 < -128) p1[r] = -1e30f; }
}

template <int MODE, int SDEPTH>
__device__ __forceinline__ void attn_unit(const bf16* __restrict__ Qb, int ldq, const float* __restrict__ qg, const float* __restrict__ rope, int q0,
                                          const bf16* __restrict__ Kh, const bf16* __restrict__ Vh, int NT, int ws_, float m_init, float l_init,
                                          const bf16* __restrict__ gate, int ldg, bf16* __restrict__ Ob, lptr lds) {
  int tid_ = threadIdx.x; asm volatile("" : "+v"(tid_));
  const int tid = tid_, wid = __builtin_amdgcn_readfirstlane(tid >> 6), lane = tid & 63, r32 = lane & 31, hi = lane >> 5;
  const lptr V_lds = lds, K_lds = lds + OFF_K;
  __attribute__((address_space(3))) float* wsf = (__attribute__((address_space(3))) float*)(lds + OFF_WS) + wid * 64;
  __attribute__((address_space(3))) float* li_l = wsf; __attribute__((address_space(3))) float* al_l = wsf + 32;
  float m_reg = m_init, l_reg = l_init; f32x16 o[4] = {}; bf16x8 qr[8];
  {
    const bf16* Qw = Qb + (long)(wid * QBLK + r32) * ldq + hi * 8;
    bf16x8 qraw[8];
#pragma unroll
    for (int d0 = 0; d0 < 8; ++d0) qraw[d0] = *(const bf16x8*)(Qw + d0 * 16);
    float rs = QS;
    if (qg) { float ss = 0.f;
#pragma unroll
      for (int d0 = 0; d0 < 8; ++d0)
#pragma unroll
        for (int j = 0; j < 8; ++j) { const float x = __uint_as_float((unsigned)(unsigned short)qraw[d0][j] << 16); ss += x * x; }
      { auto rr = __builtin_amdgcn_permlane32_swap(__float_as_uint(ss), __float_as_uint(ss), false, false); ss = __uint_as_float(rr[0]) + __uint_as_float(rr[1]); }
      rs = QS / sqrtf(ss * (1.0f / 128.0f) + 1e-6f); }
    const int tq = q0 + wid * QBLK + r32;
#pragma unroll
    for (int pr = 0; pr < 4; ++pr) { const int da = (pr >> 1) * 4 + (pr & 1), db = da + 2;
      float xa[8], xb[8];
#pragma unroll
      for (int j = 0; j < 8; ++j) { xa[j] = __uint_as_float((unsigned)(unsigned short)qraw[da][j] << 16); xb[j] = __uint_as_float((unsigned)(unsigned short)qraw[db][j] << 16); }
      if (qg) {
#pragma unroll
        for (int j = 0; j < 8; ++j) { xa[j] *= qg[da * 16 + hi * 8 + j]; xb[j] *= qg[db * 16 + hi * 8 + j]; } }
      if (rope) { const int pos = (pr < 2) ? (tq >> 6) : (tq & 63); const float* tb = rope + (long)(pos * 32 + 16 * (pr & 1) + 8 * hi) * 2;
#pragma unroll
        for (int j = 0; j < 8; ++j) { const float cs = tb[2 * j], sn = tb[2 * j + 1], ya = xa[j] * cs - xb[j] * sn, yb = xb[j] * cs + xa[j] * sn; xa[j] = ya; xb[j] = yb; } }
      u32x4 wa = {cvtpk(xa[0] * rs, xa[1] * rs), cvtpk(xa[2] * rs, xa[3] * rs), cvtpk(xa[4] * rs, xa[5] * rs), cvtpk(xa[6] * rs, xa[7] * rs)};
      u32x4 wb = {cvtpk(xb[0] * rs, xb[1] * rs), cvtpk(xb[2] * rs, xb[3] * rs), cvtpk(xb[4] * rs, xb[5] * rs), cvtpk(xb[6] * rs, xb[7] * rs)};
      qr[da] = __builtin_bit_cast(bf16x8, wa); qr[db] = __builtin_bit_cast(bf16x8, wb); }
  }
  const int sr = tid >> 4, sc = (tid & 15) * 8, vst0 = v_st(sr, sc), vst1 = v_st(32 + sr, sc);
  const int vb0 = (int)(uintptr_t)V_lds + v_rd_base(lane);
  const int kwin0 = 512 + ws_;
  const int qpos = q0 + wid * QBLK + r32;
  struct { bf16x8 vs0, vs1, ks0, ks1; } sr_[SDEPTH];
#define KOFS(t) (MODE ? ((t) < 8 ? (t) * KVBLK : kwin0 + ((t) - 8) * KVBLK) : (t) * KVBLK)
#define SLOAD(i, t) do { const int k0_ = KOFS(t); sr_[i].vs0 = *(const bf16x8*)(&Vh[(long)(k0_ + sr) * LDK + sc]); sr_[i].vs1 = *(const bf16x8*)(&Vh[(long)(k0_ + 32 + sr) * LDK + sc]); \
    sr_[i].ks0 = *(const bf16x8*)(&Kh[(long)(k0_ + sr) * LDK + sc]); sr_[i].ks1 = *(const bf16x8*)(&Kh[(long)(k0_ + 32 + sr) * LDK + sc]); } while (0)
#define SWRITE(b, i) do { *(__attribute__((address_space(3))) bf16x8*)(V_lds + (b) * SHM_V + vst0) = sr_[i].vs0;          \
    *(__attribute__((address_space(3))) bf16x8*)(V_lds + (b) * SHM_V + vst1) = sr_[i].vs1; const int kc = sc * 2;               \
    *(__attribute__((address_space(3))) bf16x8*)(K_lds + (b) * SHM_K + KSWZ(sr, kc)) = sr_[i].ks0;                       \
    *(__attribute__((address_space(3))) bf16x8*)(K_lds + (b) * SHM_K + KSWZ(32 + sr, kc)) = sr_[i].ks1; } while (0)
#define SWAIT() do { if constexpr (SDEPTH == 2) asm volatile("s_waitcnt vmcnt(4)" ::: "memory"); else asm volatile("s_waitcnt vmcnt(0)" ::: "memory"); } while (0)
#define RESC(a) do { if (__any((a) < 1.f)) { if (hi == 0) al_l[r32] = (a); asm volatile("s_waitcnt lgkmcnt(0)" ::: "memory"); \
    _Pragma("unroll") for (int d = 0; d < 4; ++d) _Pragma("unroll") for (int r = 0; r < 16; ++r) o[d][r] *= al_l[crow(r, hi)]; } } while (0)
#define WMASK(P0, P1, t) do { if (MODE && (t) >= 8) { const int kp_ = ws_ + ((t) - 8) * KVBLK; const int qw_ = q0 + wid * QBLK; \
    if (!(kp_ >= qw_ + 31 - 128 && kp_ + 63 <= qw_ + 128)) wmask(P0, P1, qpos, kp_, hi); } } while (0)
  f32x16 pA0, pA1, pB0, pB1; float mnA, mnB, alA, alB; bf16x8 pa0, pa1, pa2, pa3;
  constexpr int SE = 0, SO = SDEPTH - 1;
  SLOAD(SE, 0); asm volatile("s_waitcnt vmcnt(0)" ::: "memory"); SWRITE(0, SE); __syncthreads();
  qkt(pA0, pA1, K_lds, qr, r32, hi); partialSM(pA0, pA1, m_reg, mnA, alA);
  SLOAD(SO, 1); if constexpr (SDEPTH == 2) { if (2 < NT) SLOAD(SE, 2); }
  SWAIT(); SWRITE(1, SO); __syncthreads();
  for (int j = 1; j + 1 < NT; j += 2) {
    SBAR(); qkt(pB0, pB1, K_lds + SHM_K, qr, r32, hi); WMASK(pB0, pB1, j);
    finishSM(pA0, pA1, alA, l_reg, pa0, pa1, pa2, pa3); SBAR();
    SLOAD(SO, j + SDEPTH); SBAR();
    pv_d0(o, vb0, pa0, pa1, pa2, pa3); partialSM(pB0, pB1, m_reg, mnB, alB);
    __syncthreads(); SWAIT(); SWRITE(0, SE);
    RESC(alB); __syncthreads();
    SBAR(); qkt(pA0, pA1, K_lds, qr, r32, hi); WMASK(pA0, pA1, j + 1);
    finishSM(pB0, pB1, alB, l_reg, pa0, pa1, pa2, pa3); SBAR();
    if (SDEPTH == 1 || j + 3 < NT) SLOAD(SE, j + 1 + SDEPTH); SBAR();
    pv_d0(o, vb0 + SHM_V, pa0, pa1, pa2, pa3); partialSM(pA0, pA1, m_reg, mnA, alA);
    __syncthreads(); SWAIT(); SWRITE(1, SO);
    RESC(alA); __syncthreads();
  }
  SBAR(); qkt(pB0, pB1, K_lds + SHM_K, qr, r32, hi); WMASK(pB0, pB1, NT - 1);
  finishSM(pA0, pA1, alA, l_reg, pa0, pa1, pa2, pa3); SBAR();
  pv_d0(o, vb0, pa0, pa1, pa2, pa3); partialSM(pB0, pB1, m_reg, mnB, alB);
  __syncthreads(); RESC(alB);
  finishSM(pB0, pB1, alB, l_reg, pa0, pa1, pa2, pa3); SBAR();
  pv_d0(o, vb0 + SHM_V, pa0, pa1, pa2, pa3);
  if (hi == 0) li_l[r32] = l_reg; asm volatile("s_waitcnt lgkmcnt(0)" ::: "memory");
  float rli[16];
#pragma unroll
  for (int r = 0; r < 16; ++r) rli[r] = __builtin_amdgcn_rcpf(li_l[crow(r, hi)]);
  const lptr stg = lds + OFF_STG + wid * STG_WAVE;
#pragma unroll
  for (int r = 0; r < 16; ++r) { const int orow = crow(r, hi);
#pragma unroll
    for (int d0 = 0; d0 < 4; ++d0) { const unsigned short hv = (unsigned short)(cvtpk(o[d0][r] * rli[r], 0.f) & 0xffffu);
      *(__attribute__((address_space(3))) unsigned short*)(stg + orow * STG_ROW + (d0 * 32 + r32) * 2) = hv; } }
  asm volatile("s_waitcnt lgkmcnt(0)" ::: "memory");
#pragma unroll
  for (int i = 0; i < 8; ++i) { const int id = i * 64 + lane, row = id >> 4, ch = id & 15;
    const u32x4 ov = *(const __attribute__((address_space(3))) u32x4*)(stg + row * STG_ROW + ch * 16);
    const u32x4 gv = *(const u32x4*)(gate + (long)(wid * QBLK + row) * ldg + ch * 8);
    u32x4 w;
#pragma unroll
    for (int e = 0; e < 4; ++e) { const float g0 = __uint_as_float(gv[e] << 16), g1 = __uint_as_float(gv[e] & 0xffff0000u);
      const float x0 = __uint_as_float(ov[e] << 16), x1 = __uint_as_float(ov[e] & 0xffff0000u);
      w[e] = cvtpk(x0 * (g0 / (1.0f + __expf(-g0))), x1 * (g1 / (1.0f + __expf(-g1)))); }
    *(u32x4*)(Ob + (long)(wid * QBLK + row) * 2048 + ch * 8) = w; }
  asm volatile("s_waitcnt lgkmcnt(0)" ::: "memory");
#undef KOFS
#undef SLOAD
#undef SWRITE
#undef SWAIT
#undef RESC
#undef WMASK
}
#undef KSWZ
#undef SBAR
}

constexpr int NWAVES = 8;
#ifndef MK_N_LAUNCHES
#define MK_N_LAUNCHES 1
#endif
constexpr int NPH = 12;
constexpr int DM = 2048, NCTX = 4096, NLAT = 16384, MROWS = 20480, IN0 = 5632, IN1 = 6656;
constexpr int LD0 = 4608, LD1 = 5632;
constexpr float EPS = 1e-6f, LOG2E = 1.4426950408889634f;
constexpr float QSCALE = 0.08838834764831845f * LOG2E;

constexpr size_t MiB = 1u << 20;
constexpr size_t WS_CTL = 0, CTL_ZERO_BYTES = 1 * MiB;
constexpr size_t WS_WIN0 = 2 * MiB, WS_WOUT0 = 24 * MiB, WS_WIN1 = 32 * MiB, WS_WOUT1 = 58 * MiB;
constexpr size_t WS_MOD = 66 * MiB;
constexpr size_t WS_ROPE = 67 * MiB;
constexpr size_t WS_KL0 = 72 * MiB, WS_VL0 = 82 * MiB, WS_KL1 = 92 * MiB, WS_VL1 = 102 * MiB;
constexpr size_t WS_KC = 112 * MiB, WS_VC = 114 * MiB;
constexpr size_t WS_H = 116 * MiB;
constexpr size_t WS_PROJ = 236 * MiB;
constexpr size_t WS_END = 496 * MiB;
constexpr int CW_BAR = 4096;
constexpr size_t OUT_K0 = (size_t)MROWS * DM, OUT_V0 = OUT_K0 + 1048576, OUT_K1 = OUT_K0 + 2 * 1048576, OUT_V1 = OUT_K0 + 3 * 1048576;

constexpr int RING_BYTES = 131072, LDS_BYTES = 147456, LDSCTL_OFF = LDS_BYTES - 1024, MISC_OFF = LDSCTL_OFF + 320;
static_assert(att::ATT_LDS <= LDSCTL_OFF, "attention scratch vs LDS control words");

struct Args { const float* in[27]; float* out; unsigned char* ws; int ph_lo, ph_hi; };

struct Frame {
    LAS unsigned char* lds;
    volatile LAS unsigned* MISC;
    int tid, lane, wave, vcu, G;
};

__device__ __forceinline__ float bf_lo(unsigned u) { return __uint_as_float(u << 16); }
__device__ __forceinline__ float bf_hi(unsigned u) { return __uint_as_float(u & 0xffff0000u); }
__device__ __forceinline__ float sigmoidf_(float x) { return 1.0f / (1.0f + __expf(-x)); }
__device__ __forceinline__ float siluf_(float x) { return x / (1.0f + __expf(-x)); }
__device__ __forceinline__ float wave_sum(float v) {
#pragma unroll
    for (int o = 1; o < 64; o <<= 1) v += __shfl_xor(v, o);
    return v;
}

template <int MAP> __device__ __forceinline__ void p0_transpose_item(const float* W, int K, int N, bf16* WT, LAS float* scr, int item, int lane) {
    const int nblk = N / 32, kb = item / nblk, nb = item % nblk, k0 = 64 * kb, n0 = 32 * nb;
    int d0 = n0;
    if (MAP == 1) { if (n0 < 1024) d0 = (n0 >> 7) * 256 + (n0 & 127); else if (n0 < 2048) d0 = ((n0 - 1024) >> 7) * 256 + 128 + (n0 & 127); }
    if (MAP == 2) { if (n0 >= 3584 && n0 < 4608) d0 = 3584 + ((n0 - 3584) >> 7) * 256 + (n0 & 127); else if (n0 >= 4608 && n0 < 5632) d0 = 3584 + ((n0 - 4608) >> 7) * 256 + 128 + (n0 & 127); }
#pragma unroll 8
    for (int i = 0; i < 32; ++i) { const int kk = 2 * i + (lane >> 5); scr[kk * 33 + (lane & 31)] = W[(size_t)(k0 + kk) * N + n0 + (lane & 31)]; }
    LDS_WAIT(); asm volatile("" ::: "memory");
    const int c = lane & 7;
#pragma unroll
    for (int j = 0; j < 4; ++j) { const int n = (lane >> 3) + 8 * j; const LAS float* s = scr + (8 * c) * 33 + n;
        v4u o; o.x = pk2(s[0 * 33], s[1 * 33]); o.y = pk2(s[2 * 33], s[3 * 33]); o.z = pk2(s[4 * 33], s[5 * 33]); o.w = pk2(s[6 * 33], s[7 * 33]);
        *(GAS v4u*)(WT + (size_t)(d0 + n) * K + k0 + 8 * c) = o; }
    LDS_WAIT(); asm volatile("" ::: "memory");
}

__device__ __forceinline__ void p0_prologue(Frame& F, const Args& a) {
    unsigned char* ws = a.ws;
    float* MOD = (float*)(ws + WS_MOD);
    {
        LAS float* red = (LAS float*)F.lds;
        for (int it = blockIdx.x; it < 192; it += F.G) {
            const int l = it / 96, cg = it % 96, n = cg * 64 + F.lane, kb = F.wave * 256;
            const float* W = a.in[l ? 19 : 8]; const float* bias = a.in[l ? 20 : 9];
            float cs[9][4];
#pragma unroll
            for (int r = 0; r < 9; ++r)
#pragma unroll
                for (int j = 0; j < 4; ++j) { const int k = kb + 64 * j + F.lane; const float x = (r < 8) ? a.in[6][r * DM + k] : a.in[7][k]; cs[r][j] = x / (1.0f + expf(-x)); }
            float acc[9];
#pragma unroll
            for (int r = 0; r < 9; ++r) acc[r] = 0.f;
#pragma unroll
            for (int j = 0; j < 4; ++j) {
#pragma unroll 8
                for (int kk = 0; kk < 64; ++kk) {
                    const float w = W[(size_t)(kb + 64 * j + kk) * 6144 + n];
#pragma unroll
                    for (int r = 0; r < 9; ++r) acc[r] += __int_as_float(__builtin_amdgcn_readlane(__float_as_int(cs[r][j]), kk)) * w;
                }
            }
#pragma unroll
            for (int r = 0; r < 9; ++r) red[(F.wave * 9 + r) * 64 + F.lane] = acc[r];
            __syncthreads();
            for (int idx = F.tid; idx < 576; idx += 512) { const int r = idx >> 6, ln = idx & 63; float s = 0.f;
#pragma unroll
                for (int w = 0; w < 8; ++w) s += red[(w * 9 + r) * 64 + ln];
                MOD[(size_t)(l * 9 + r) * 6144 + cg * 64 + ln] = s + bias[cg * 64 + ln]; }
            __syncthreads();
        }
    }
    LAS float* scr = (LAS float*)(F.lds + F.wave * 16384);
    const int gw = F.vcu * NWAVES + F.wave, NGW = F.G * NWAVES;
    constexpr int I_IN0 = 32 * (IN0 / 32), I_OUT = 32 * (DM / 32), I_IN1 = 32 * (IN1 / 32), I_T = I_IN0 + I_OUT + I_IN1 + I_OUT, I_C = 4 * 2048, I_R = 32;
    for (int it = gw; it < I_T + I_C + I_R; it += NGW) {
        int r = it;
        if (r < I_IN0) { p0_transpose_item<1>(a.in[11], DM, IN0, (bf16*)(ws + WS_WIN0), scr, r, F.lane); continue; } r -= I_IN0;
        if (r < I_OUT) { p0_transpose_item<0>(a.in[18], DM, DM, (bf16*)(ws + WS_WOUT0), scr, r, F.lane); continue; } r -= I_OUT;
        if (r < I_IN1) { p0_transpose_item<2>(a.in[22], DM, IN1, (bf16*)(ws + WS_WIN1), scr, r, F.lane); continue; } r -= I_IN1;
        if (r < I_OUT) { p0_transpose_item<0>(a.in[25], DM, DM, (bf16*)(ws + WS_WOUT1), scr, r, F.lane); continue; } r -= I_OUT;
        if (r < I_C) {
            const int ts = r >> 11, wi = r & 2047, e0 = wi * 512 + F.lane * 8;
            const float* src = a.in[2 + ts] + e0;
            const f32x4 v0 = *(const f32x4*)src, v1 = *(const f32x4*)(src + 4);
            bf16* dst = (bf16*)(ws + (ts == 0 ? WS_KL0 : ts == 1 ? WS_VL0 : ts == 2 ? WS_KL1 : WS_VL1)) + (size_t)(e0 >> 17) * (2560 * 256) + (e0 & 131071);
            v4u o; o.x = pk2(v0[0], v0[1]); o.y = pk2(v0[2], v0[3]); o.z = pk2(v1[0], v1[1]); o.w = pk2(v1[2], v1[3]);
            *(v4u*)dst = o; continue; }
        r -= I_C;
        {
            const int idx = r * 64 + F.lane, pos = idx >> 5, j = idx & 31;
            const float inv = exp2f(-(float)j * (13.287712379549449f / 32.0f));
            double rev = (double)pos * (double)inv * 0.15915494309189535; rev -= floor(rev);
            float* T = (float*)(ws + WS_ROPE) + idx * 2;
            T[0] = __builtin_amdgcn_cosf((float)rev); T[1] = __builtin_amdgcn_sinf((float)rev);
        }
    }
}

__device__ __forceinline__ void h_rows(Frame& F, const Args& a, int layer, const float* xp, const float* xs, const float* g) {
    const float* MOD = (const float*)(a.ws + WS_MOD); bf16* H = (bf16*)(a.ws + WS_H);
    const int gw = F.vcu * NWAVES + F.wave, NGW = F.G * NWAVES;
    for (int row = gw; row < MROWS; row += NGW) {
        const float* src = row < NCTX ? xp + (size_t)row * DM : xs + (size_t)(row - NCTX) * DM;
        const int cr = row < NCTX ? 8 : ((row - NCTX) >> 11);
        const float* mod = MOD + (size_t)(layer * 9 + cr) * 6144;
        f32x4 v[8]; float ss = 0.f;
#pragma unroll
        for (int j = 0; j < 8; ++j) { v[j] = *(const f32x4*)(src + j * 256 + F.lane * 4); ss += (v[j][0] * v[j][0] + v[j][1] * v[j][1]) + (v[j][2] * v[j][2] + v[j][3] * v[j][3]); }
        const float rstd = 1.0f / sqrtf(wave_sum(ss) * (1.0f / DM) + EPS);
#pragma unroll
        for (int j = 0; j < 8; ++j) { const int c = j * 256 + F.lane * 4;
            const f32x4 gg = *(const f32x4*)(g + c), sh = *(const f32x4*)(mod + c), sc = *(const f32x4*)(mod + 2048 + c);
            const f32x4 y = (v[j] * rstd) * gg; const f32x4 h = y * (sc + 1.0f) + sh;
            unsigned long long o = (unsigned long long)pk2(h[0], h[1]) | ((unsigned long long)pk2(h[2], h[3]) << 32);
            *(unsigned long long*)(H + (size_t)row * DM + c) = o; }
    }
}

__device__ __forceinline__ void final_rows(Frame& F, const Args& a) {
    const float* g = a.in[26];
    const int gw = F.vcu * NWAVES + F.wave, NGW = F.G * NWAVES;
    for (int row = gw; row < MROWS; row += NGW) {
        float* p = a.out + (size_t)row * DM;
        f32x4 v[8]; float ss = 0.f;
#pragma unroll
        for (int j = 0; j < 8; ++j) { v[j] = *(const f32x4*)(p + j * 256 + F.lane * 4); ss += (v[j][0] * v[j][0] + v[j][1] * v[j][1]) + (v[j][2] * v[j][2] + v[j][3] * v[j][3]); }
        const float rstd = 1.0f / sqrtf(wave_sum(ss) * (1.0f / DM) + EPS);
#pragma unroll
        for (int j = 0; j < 8; ++j) { const int c = j * 256 + F.lane * 4; const f32x4 gg = *(const f32x4*)(g + c); *(f32x4*)(p + c) = (v[j] * rstd) * gg; }
    }
}

template <int R> struct ConvStep {
    static __device__ __forceinline__ void run(f32x2 (&out)[32], const f32x2 (&w)[31], const bf16* P, int rowbase, int S, int t0, int tid) {
        const int t = t0 - 15 + R; const bool valid = (t >= 0) && (t < S); const int tc = t < 0 ? 0 : (t >= S ? S - 1 : t);
        const unsigned ga = *(const unsigned*)(P + (size_t)(rowbase + tc) * LD0 + 2 * tid);
        f32x2 av; av.x = bf_lo(ga); av.y = bf_hi(ga);
        if (!valid) { av.x = 0.f; av.y = 0.f; }
#pragma unroll
        for (int j = 0; j < 31; ++j) { const int tp = R - j; if (tp >= 0 && tp < 32) out[tp] += w[j] * av; }
        ConvStep<R + 1>::run(out, w, P, rowbase, S, t0, tid);
    }
};
template <> struct ConvStep<62> { static __device__ __forceinline__ void run(f32x2 (&)[32], const f32x2 (&)[31], const bf16*, int, int, int, int) {} };

__device__ __forceinline__ void conv0_items(Frame& F, const Args& a) {
    const bf16* P = (const bf16*)(a.ws + WS_PROJ); bf16* MIX = (bf16*)(a.ws + WS_H);
    const float* cw = a.in[12]; const float* cb = a.in[13]; const float* lng = a.in[14]; const float* lnb = a.in[15];
    LAS float* cv = (LAS float*)F.lds;
    int tid = F.tid; asm volatile("" : "+v"(tid));
    f32x2 w[31];
#pragma unroll
    for (int j = 0; j < 31; ++j) w[j] = *(const f32x2*)(cw + j * 1024 + 2 * tid);
    const f32x2 bias = *(const f32x2*)(cb + 2 * tid);
    for (int ci = blockIdx.x; ci < 640; ci += F.G) {
        int rowbase, S, t0;
        if (ci < 128) { rowbase = (ci >> 3) * 256; S = 256; t0 = (ci & 7) * 32; } else { const int li = ci - 128; rowbase = NCTX + (li >> 6) * 2048; S = 2048; t0 = (li & 63) * 32; }
        f32x2 out[32];
#pragma unroll
        for (int i = 0; i < 32; ++i) out[i] = bias;
        ConvStep<0>::run(out, w, P, rowbase, S, t0, tid);
#pragma unroll
        for (int i = 0; i < 32; ++i) *(LAS f32x2*)(cv + i * 1024 + 2 * tid) = out[i];
        __syncthreads();
#pragma unroll 1
        for (int i = 0; i < 4; ++i) {
            const int tp = F.wave * 4 + i; const size_t row = (size_t)(rowbase + t0 + tp);
            f32x4 x[4]; float s = 0.f;
#pragma unroll
            for (int q = 0; q < 4; ++q) { x[q] = *(const LAS f32x4*)(cv + tp * 1024 + q * 256 + F.lane * 4); s += (x[q][0] + x[q][1]) + (x[q][2] + x[q][3]); }
            const float mean = wave_sum(s) * (1.0f / 1024.0f); float s2 = 0.f;
#pragma unroll
            for (int q = 0; q < 4; ++q) { x[q] = x[q] - mean; s2 += (x[q][0] * x[q][0] + x[q][1] * x[q][1]) + (x[q][2] * x[q][2] + x[q][3] * x[q][3]); }
            const float rstd = 1.0f / sqrtf(wave_sum(s2) * (1.0f / 1024.0f) + EPS);
#pragma unroll
            for (int q = 0; q < 4; ++q) { const int c = q * 256 + F.lane * 4;
                const f32x4 g4 = *(const f32x4*)(lng + c), b4 = *(const f32x4*)(lnb + c);
                const f32x4 y = (x[q] * rstd) * g4 + b4;
                const unsigned long long gt = *(const unsigned long long*)(P + row * LD0 + 1024 + c);
                const unsigned glo = (unsigned)gt, ghi = (unsigned)(gt >> 32);
                const float o0 = siluf_(y[0]) * siluf_(bf_lo(glo)), o1 = siluf_(y[1]) * siluf_(bf_hi(glo)), o2 = siluf_(y[2]) * siluf_(bf_lo(ghi)), o3 = siluf_(y[3]) * siluf_(bf_hi(ghi));
                *(unsigned long long*)(MIX + row * DM + c) = (unsigned long long)pk2(o0, o1) | ((unsigned long long)pk2(o2, o3) << 32); }
        }
        __syncthreads();
    }
}

template <int LAYER> __device__ __forceinline__ void kprep_rows(Frame& F, const Args& a) {
    constexpr int ldc = LAYER ? LD1 : LD0, koff = LAYER ? 1024 : 3072, R0 = LAYER ? NCTX : 0;
    const bf16* P = (const bf16*)(a.ws + WS_PROJ);
    bf16* KL = (bf16*)(a.ws + (LAYER ? WS_KL1 : WS_KL0)); bf16* KC = (bf16*)(a.ws + WS_KC);
    const float* ROPE = (const float*)(a.ws + WS_ROPE); const float* kg = a.in[17];
    const int gw = F.vcu * NWAVES + F.wave, NGW = F.G * NWAVES, lane = F.lane, li = lane & 15, c = li & 7;
    for (int it = gw; it < (MROWS - R0) / 4; it += NGW) {
        const int row = R0 + it * 4 + (lane >> 4); const bool lat = row >= NCTX;
        const int t = (row - NCTX) & 2047, b = (row - NCTX) >> 11;
        const bf16* src = P + (size_t)row * ldc + koff + li * 16;
        const v4u r0 = *(const v4u*)src, r1 = *(const v4u*)(src + 8);
        float x[16];
        x[0] = bf_lo(r0.x); x[1] = bf_hi(r0.x); x[2] = bf_lo(r0.y); x[3] = bf_hi(r0.y); x[4] = bf_lo(r0.z); x[5] = bf_hi(r0.z); x[6] = bf_lo(r0.w); x[7] = bf_hi(r0.w);
        x[8] = bf_lo(r1.x); x[9] = bf_hi(r1.x); x[10] = bf_lo(r1.y); x[11] = bf_hi(r1.y); x[12] = bf_lo(r1.z); x[13] = bf_hi(r1.z); x[14] = bf_lo(r1.w); x[15] = bf_hi(r1.w);
        if (LAYER == 0) {
            float ss = 0.f;
#pragma unroll
            for (int e = 0; e < 16; ++e) ss += x[e] * x[e];
            ss += __shfl_xor(ss, 1); ss += __shfl_xor(ss, 2); ss += __shfl_xor(ss, 4);
            const float rstd = 1.0f / sqrtf(ss * (1.0f / 128.0f) + EPS);
            const float* gp = kg + c * 16;
#pragma unroll
            for (int e = 0; e < 16; ++e) x[e] = (x[e] * rstd) * gp[e];
        }
        if (lat) {
            const int cc = c & 3, pos = (c < 4) ? (t >> 6) : (t & 63); const bool first = cc < 2;
            const float* tb = ROPE + (size_t)(pos * 32 + 16 * (cc & 1)) * 2;
#pragma unroll
            for (int e = 0; e < 16; ++e) { const float pv = __shfl_xor(x[e], 2); const float cs = tb[2 * e], sn = tb[2 * e + 1]; x[e] = first ? (x[e] * cs - pv * sn) : (x[e] * cs + pv * sn); }
        }
        v4u o0, o1;
        o0.x = pk2(x[0], x[1]); o0.y = pk2(x[2], x[3]); o0.z = pk2(x[4], x[5]); o0.w = pk2(x[6], x[7]);
        o1.x = pk2(x[8], x[9]); o1.y = pk2(x[10], x[11]); o1.z = pk2(x[12], x[13]); o1.w = pk2(x[14], x[15]);
        bf16* dst = lat ? KL + ((size_t)b * 2560 + 512 + t) * 256 + li * 16 : KC + (size_t)row * 256 + li * 16;
        *(v4u*)dst = o0; *(v4u*)(dst + 8) = o1;
        if (LAYER == 0 && !lat) { float* ko = a.out + OUT_K0 + (size_t)row * 256 + li * 16;
#pragma unroll
            for (int e = 0; e < 16; e += 4) *(f32x4*)(ko + e) = (f32x4){x[e], x[e + 1], x[e + 2], x[e + 3]}; }
    }
}

__device__ __forceinline__ void conv1_rows(Frame& F, const Args& a) {
    const bf16* P = (const bf16*)(a.ws + WS_PROJ); bf16* MIX = (bf16*)(a.ws + WS_H); const float* sw = a.in[24];
    const int gw = F.vcu * NWAVES + F.wave, NGW = F.G * NWAVES;
    for (int it = gw; it < MROWS * 2; it += NGW) {
        const int row = it >> 1, c0 = (it & 1) * 512 + F.lane * 8;
        int t, S; if (row < NCTX) { t = row & 255; S = 256; } else { t = (row - NCTX) & 2047; S = 2048; }
        const bf16* pr = P + (size_t)row * LD1;
        float cvv[8];
#pragma unroll
        for (int e = 0; e < 8; ++e) cvv[e] = 0.f;
#pragma unroll
        for (int j = 0; j < 3; ++j) {
            const int tt = t + j - 1;
            if (tt >= 0 && tt < S) {
                const bf16* pq = pr + (ptrdiff_t)(j - 1) * LD1;
                const v4u pp = *(const v4u*)(pq + 3584 + c0);
                const f32x4 w0 = *(const f32x4*)(sw + j * 1024 + c0), w1 = *(const f32x4*)(sw + j * 1024 + c0 + 4);
                cvv[0] += w0[0] * bf_lo(pp.x); cvv[1] += w0[1] * bf_hi(pp.x); cvv[2] += w0[2] * bf_lo(pp.y); cvv[3] += w0[3] * bf_hi(pp.y);
                cvv[4] += w1[0] * bf_lo(pp.z); cvv[5] += w1[1] * bf_hi(pp.z); cvv[6] += w1[2] * bf_lo(pp.w); cvv[7] += w1[3] * bf_hi(pp.w);
            }
        }
        const v4u db = *(const v4u*)(pr + 2560 + c0), gd = *(const v4u*)(pr + 4608 + c0);
        v4u o;
        o.x = pk2(bf_lo(db.x) * cvv[0] * siluf_(bf_lo(gd.x)), bf_hi(db.x) * cvv[1] * siluf_(bf_hi(gd.x)));
        o.y = pk2(bf_lo(db.y) * cvv[2] * siluf_(bf_lo(gd.y)), bf_hi(db.y) * cvv[3] * siluf_(bf_hi(gd.y)));
        o.z = pk2(bf_lo(db.z) * cvv[4] * siluf_(bf_lo(gd.z)), bf_hi(db.z) * cvv[5] * siluf_(bf_hi(gd.z)));
        o.w = pk2(bf_lo(db.w) * cvv[6] * siluf_(bf_lo(gd.w)), bf_hi(db.w) * cvv[7] * siluf_(bf_hi(gd.w)));
        *(v4u*)(MIX + (size_t)row * DM + 1024 + c0) = o;
    }
}

template <int LAYER> __device__ __forceinline__ void attn_phase(Frame& F, const Args& a) {
    constexpr int ldc = LAYER ? LD1 : LD0, qoff = LAYER ? 0 : 2048, goff = LAYER ? 1536 : 3584, ocol = LAYER ? 0 : 1024;
    const bf16* P = (const bf16*)(a.ws + WS_PROJ); bf16* MIX = (bf16*)(a.ws + WS_H);
    const bf16* KL = (const bf16*)(a.ws + (LAYER ? WS_KL1 : WS_KL0)); const bf16* VL = (const bf16*)(a.ws + (LAYER ? WS_VL1 : WS_VL0));
    const bf16* KC = (const bf16*)(a.ws + WS_KC); const bf16* VC = (const bf16*)(a.ws + WS_VC);
    const float* sink = a.in[23]; const float* qg = LAYER ? nullptr : a.in[16]; const float* ROPE = (const float*)(a.ws + WS_ROPE);
    const att::lptr lds = (att::lptr)F.lds;
    const int per = (512 + F.G - 1) / F.G;
    for (int i = 0; i < per; ++i) {
        const int u = F.vcu * per + i; if (u >= 512) break;
        const int grp = u >> 5, g = (u >> 3) & 3, qb = u & 7, b = grp >> 1, kvh = grp & 1, h = kvh * 4 + g;
        const size_t row0 = (size_t)NCTX + (size_t)b * 2048 + qb * 256; const size_t ko = (size_t)b * (2560 * 256) + kvh * 128;
        const float m0 = LAYER ? sink[h] * LOG2E : -1e30f, l0 = LAYER ? 1.f : 0.f; const int q0 = qb * 256;
        if (LAYER == 0) att::attn_unit<0, 1>(P + row0 * ldc + qoff + h * 128, ldc, qg, ROPE, q0, KL + ko, VL + ko, 40, 0, m0, l0, P + row0 * ldc + goff + h * 128, ldc, MIX + row0 * DM + ocol + h * 128, lds);
        else { const int wsl = q0 >= 128 ? q0 - 128 : 0, wel = q0 + 384 <= 2048 ? q0 + 384 : 2048;
            att::attn_unit<1, 1>(P + row0 * ldc + qoff + h * 128, ldc, qg, ROPE, q0, KL + ko, VL + ko, 8 + (wel - wsl) / 64, wsl, m0, l0, P + row0 * ldc + goff + h * 128, ldc, MIX + row0 * DM + ocol + h * 128, lds); }
    }
    const int stride = F.G >= 256 ? F.G / 128 : 1;
    if (F.vcu % stride == 0) {
        for (int c = F.vcu / stride; c < 128; c += (F.G + stride - 1) / stride) {
            const int s = c >> 3, h = c & 7, kvh = h >> 2; const size_t row0 = (size_t)s * 256; const size_t ko = (size_t)s * 65536 + kvh * 128;
            const float m0 = LAYER ? sink[h] * LOG2E : -1e30f, l0 = LAYER ? 1.f : 0.f;
            att::attn_unit<0, 1>(P + row0 * ldc + qoff + h * 128, ldc, qg, nullptr, 0, KC + ko, VC + ko, 4, 0, m0, l0, P + row0 * ldc + goff + h * 128, ldc, MIX + row0 * DM + ocol + h * 128, lds);
        }
    }
}

__global__ void __launch_bounds__(NWAVES * 64, 2) mk_fwd(Args args) {
    extern __shared__ __attribute__((aligned(16))) unsigned char lds[];
    Frame F;
    F.lds = (LAS unsigned char*)lds;
    F.MISC = (volatile LAS unsigned*)(F.lds + MISC_OFF);
    F.tid = threadIdx.x; F.lane = F.tid & 63; F.wave = __builtin_amdgcn_readfirstlane(F.tid >> 6);
    F.G = gridDim.x; { const int bx = blockIdx.x; F.vcu = (F.G % 8 == 0) ? (bx % 8) * (F.G / 8) + bx / 8 : bx; }
    unsigned char* ws = args.ws;
    gu32* ctl = (gu32*)(ws + WS_CTL);
    for (int u = F.tid; u < (LDS_BYTES - LDSCTL_OFF) / 4; u += NWAVES * 64) ((LAS unsigned*)(F.lds + LDSCTL_OFF))[u] = 0u;
    __syncthreads();
    const int lo = args.ph_lo, hi = args.ph_hi;
    XcdBarrier bar; bar.bar = (unsigned*)(ctl + CW_BAR); bar.x = 0; bar.st = nullptr;
    if (hi - lo > 1) bar = xcd_barrier_post((unsigned*)(ctl + CW_BAR), F.MISC + 8);
#define IN(k) (lo <= (k) && (k) < hi)
#ifndef PROBE_REPEAT
#define PROBE_REPEAT 0
#endif
#define REP(k) for (int rep_ = 0; rep_ < 1 + ((PROBE_REPEAT >> (k)) & 1); ++rep_)
#define SEAM(k) do { if (IN(k) && IN((k) + 1)) xcd_barrier(bar); } while (0)
    bf16* Hb = (bf16*)(ws + WS_H); bf16* PROJ = (bf16*)(ws + WS_PROJ);
    const float* MOD = (const float*)(ws + WS_MOD);

    if (IN(0)) REP(0) { p0_prologue(F, args); } SEAM(0);
    if (IN(1)) REP(1) { h_rows(F, args, 0, args.in[0], args.in[1], args.in[10]); } SEAM(1);
    if (IN(2)) REP(2) {
        pg8::Gemm g{Hb, (const bf16*)(ws + WS_WIN0), MROWS, IN0, DM}; pg8::StaticOrder S; S.init(MROWS, IN0, F.G, (int)blockIdx.x);
        pg8::EpiProj E{PROJ, LD0, 0, 8, 0, 17, (bf16*)(ws + WS_VL0), (bf16*)(ws + WS_VC), args.out + OUT_V0, -1, nullptr, nullptr};
        pg8::gemm_phase<pg8::EpiProj, pg8::StaticOrder, true, true>(F.lds, g, S, E);
    } SEAM(2);
    if (IN(3)) { REP(12) conv0_items(F, args); REP(13) kprep_rows<0>(F, args); } SEAM(3);
    if (IN(4)) REP(4) { attn_phase<0>(F, args); } SEAM(4);
    if (IN(5)) REP(5) {
        pg8::Gemm g{Hb, (const bf16*)(ws + WS_WOUT0), MROWS, DM, DM}; pg8::StaticOrder S; S.init(MROWS, DM, F.G, (int)blockIdx.x);
        pg8::EpiRes E{args.in[0], args.in[1], args.out, MOD + 4096};
        pg8::gemm_phase<pg8::EpiRes, pg8::StaticOrder, true, true>(F.lds, g, S, E);
    } SEAM(5);
    if (IN(6)) REP(6) { h_rows(F, args, 1, args.out, args.out + (size_t)NCTX * DM, args.in[21]); } SEAM(6);
    if (IN(7)) REP(7) {
        pg8::Gemm g{Hb, (const bf16*)(ws + WS_WIN1), MROWS, IN1, DM}; pg8::StaticOrder S; S.init(MROWS, IN1, F.G, (int)blockIdx.x);
        pg8::EpiProj E{PROJ, LD1, 14, 22, 1, 5, (bf16*)(ws + WS_VL1), (bf16*)(ws + WS_VC), args.out + OUT_V1, 4, (bf16*)(ws + WS_KC), args.out + OUT_K1};
        pg8::gemm_phase<pg8::EpiProj, pg8::StaticOrder, true, true>(F.lds, g, S, E);
    } SEAM(7);
    if (IN(8)) { REP(14) conv1_rows(F, args); REP(15) kprep_rows<1>(F, args); } SEAM(8);
    if (IN(9)) REP(9) { attn_phase<1>(F, args); } SEAM(9);
    if (IN(10)) {
        pg8::Gemm g{Hb, (const bf16*)(ws + WS_WOUT1), MROWS, DM, DM}; pg8::StaticOrder S; S.init(MROWS, DM, F.G, (int)blockIdx.x);
        pg8::EpiRes E{args.out, args.out + (size_t)NCTX * DM, args.out, MOD + 9 * 6144 + 4096};
        pg8::gemm_phase<pg8::EpiRes, pg8::StaticOrder, true, true>(F.lds, g, S, E);
    } SEAM(10);
    if (IN(11)) { final_rows(F, args); }
#undef IN
#undef SEAM
}

extern "C" void kernel_launch(void* const* d_in, const int* in_sizes, int n_in, void* d_out, int out_size, void* d_ws, size_t ws_size, hipStream_t stream) {
    static int grid = 0;
    if (grid == 0) {
        if (n_in != 27 || out_size != (int)(OUT_K0 + 4 * 1048576) || ws_size < WS_END) { fprintf(stderr, "kernel_launch: unexpected problem shape: n_in %d out %d ws %zu; nothing launched\n", n_in, out_size, ws_size); grid = -1; return; }
        int dev = 0, cus = 0;
        if (hipGetDevice(&dev) != hipSuccess || hipDeviceGetAttribute(&cus, hipDeviceAttributeMultiprocessorCount, dev) != hipSuccess) { grid = -1; return; }
        if (hipFuncSetAttribute((const void*)mk_fwd, hipFuncAttributeMaxDynamicSharedMemorySize, LDS_BYTES) != hipSuccess) { fprintf(stderr, "kernel_launch: hipFuncSetAttribute failed\n"); grid = -1; return; }
        int per_cu = 0;
        if (hipOccupancyMaxActiveBlocksPerMultiprocessor(&per_cu, (const void*)mk_fwd, NWAVES * 64, LDS_BYTES) != hipSuccess || per_cu < 1) fprintf(stderr, "kernel_launch: note: occupancy query reports %d workgroups per CU\n", per_cu);
        (void)hipGetLastError();
        grid = cus;
    }
    if (grid < 0) return;
    if (hipMemsetAsync((char*)d_ws + WS_CTL, 0, CTL_ZERO_BYTES, stream) != hipSuccess) { fprintf(stderr, "kernel_launch: hipMemsetAsync failed\n"); return; }
    Args a{};
    for (int i = 0; i < 27; ++i) a.in[i] = (const float*)d_in[i];
    a.out = (float*)d_out; a.ws = (unsigned char*)d_ws;
#if MK_N_LAUNCHES == 1
    a.ph_lo = 0; a.ph_hi = NPH;
    hipLaunchKernelGGL(mk_fwd, dim3(grid), dim3(NWAVES * 64), LDS_BYTES, stream, a);
#else
    for (int p = 0; p < NPH; ++p) { a.ph_lo = p; a.ph_hi = p + 1; hipLaunchKernelGGL(mk_fwd, dim3(grid), dim3(NWAVES * 64), LDS_BYTES, stream, a); }
#endif
    const hipError_t le = hipPeekAtLastError();
    if (le != hipSuccess) fprintf(stderr, "kernel_launch: launch failed: %s\n", hipGetErrorName(le));
}
```
